# Optimizing an MI355X kernel written in HIP

```python
import math
import numpy as np
import jax
import jax.numpy as jnp
from jax import lax

D_MODEL = 1024
BATCH = 8
SEQ = 2048
DEPTH = 2

CTX_LEN = 256
GRID_W = 64
Q_BLOCK = 128
ROPE_BASE = 10000.0
NEG_INF = -1e30
EPS = 1e-6
N_ADA = 6

MLA_HEADS = 4
MLA_NOPE = 64
MLA_ROPE = 32
MLA_V = 64
MLA_Q_RANK = 256
MLA_KV_RANK = 128
MLA_SCALE = (MLA_NOPE + MLA_ROPE) ** -0.5
DIFF_HEADS = 4
DIFF_QK = 32
DIFF_V = 2 * DIFF_QK
DIFF_SCALE = DIFF_QK ** -0.5
WIN_HEADS = 4
WIN_KV_HEADS = 2
WIN_GROUP = WIN_HEADS // WIN_KV_HEADS
WIN_DIM = 64
WINDOW = 128
WIN_SCALE = WIN_DIM ** -0.5
NA_HEADS = 4
NA_DIM = 64
NA_ROWS = 8
NA_COLS = 16
NA_SCALE = NA_DIM ** -0.5
FFN_HIDDEN = 4 * D_MODEL

N_BRANCH = 4
BRANCH_WIDTHS = (MLA_HEADS * MLA_V, DIFF_HEADS * DIFF_V, WIN_HEADS * WIN_DIM, NA_HEADS * NA_DIM)
MIX_WIDTH = sum(BRANCH_WIDTHS)
IN_SPLITS = (MLA_Q_RANK, MLA_KV_RANK, MLA_ROPE,
             DIFF_HEADS * 2 * DIFF_QK, DIFF_HEADS * 2 * DIFF_QK, DIFF_HEADS * DIFF_V,
             WIN_HEADS * WIN_DIM, WIN_KV_HEADS * WIN_DIM, WIN_KV_HEADS * WIN_DIM,
             NA_HEADS * NA_DIM, NA_HEADS * NA_DIM, NA_HEADS * NA_DIM)
IN_WIDTH = sum(IN_SPLITS)

kernel_name = 'hybrid_gated_mixer_dit_block'


def rmsnorm(x, g):
    xf = x.astype(jnp.float32)
    y = xf * lax.rsqrt(jnp.mean(xf * xf, axis=-1, keepdims=True) + EPS)
    return (y * g.astype(jnp.float32)).astype(x.dtype)


def adaln(x, g, shift, scale):
    return rmsnorm(x, g) * (1 + scale) + shift


def split_columns(p):
    offsets = np.cumsum(IN_SPLITS)[:-1].tolist()
    return jnp.split(p, offsets, axis=-1)


def axial_rope_tables(n_tokens, dim):
    quarter = dim // 4
    inv_freq = ROPE_BASE ** (-jnp.arange(quarter, dtype=jnp.float32) / quarter)
    t = jnp.arange(n_tokens, dtype=jnp.int32)
    row = (t // GRID_W).astype(jnp.float32)[:, None] * inv_freq
    col = (t % GRID_W).astype(jnp.float32)[:, None] * inv_freq
    ang = jnp.concatenate([row, row, col, col], axis=-1)
    return jnp.cos(ang), jnp.sin(ang)


def rope2d(x, rope):
    cos, sin = rope
    x1, x2, x3, x4 = jnp.split(x, 4, axis=-1)
    rot = jnp.concatenate([-x2, x1, -x4, x3], axis=-1)
    return x * cos[:, None].astype(x.dtype) + rot * sin[:, None].astype(x.dtype)


def sweep_query_blocks(fn, *qs):
    B, n = qs[0].shape[:2]
    nb = n // Q_BLOCK
    blocks = tuple(jnp.moveaxis(q.reshape(B, nb, Q_BLOCK, *q.shape[2:]), 1, 0) for q in qs)
    out = lax.map(lambda args: fn(*args), blocks)
    return jnp.moveaxis(out, 0, 1).reshape(B, n, *out.shape[3:])


def dense_attention(q, k, v, scale):
    s = jnp.einsum('bqhd,bkhd->bhqk', q, k).astype(jnp.float32) * scale
    p = jax.nn.softmax(s, axis=-1).astype(v.dtype)
    return jnp.einsum('bhqk,bkhd->bqhd', p, v)


def mla_branch(lat, ctx, q_norm, kv_norm, w_uq, w_ukv, rope, need_ctx):
    cq_l, ckv_l, kr_l = lat
    cq_c, ckv_c, kr_c = ctx
    B, n = cq_l.shape[:2]

    def up_q(c_q):
        q = (rmsnorm(c_q, q_norm) @ w_uq).reshape(c_q.shape[0], c_q.shape[1], MLA_HEADS, MLA_NOPE + MLA_ROPE)
        return q[..., :MLA_NOPE], q[..., MLA_NOPE:]

    def up_kv(c_kv):
        kv = (rmsnorm(c_kv, kv_norm) @ w_ukv).reshape(c_kv.shape[0], c_kv.shape[1], MLA_HEADS, MLA_NOPE + MLA_V)
        return kv[..., :MLA_NOPE], kv[..., MLA_NOPE:]

    def attend(qn, qr, kn, kr, v):
        s = (jnp.einsum('bqhd,bkhd->bhqk', qn, kn)
             + jnp.einsum('bqhr,bkr->bhqk', qr, kr)).astype(jnp.float32) * MLA_SCALE
        p = jax.nn.softmax(s, axis=-1).astype(v.dtype)
        return jnp.einsum('bhqk,bkhd->bqhd', p, v)

    qn_l, qr_l = up_q(cq_l)
    qr_l = rope2d(qr_l, rope)
    kn_l, v_l = up_kv(ckv_l)
    kr_l = rope2d(kr_l[:, :, None, :], rope)[:, :, 0, :]
    kn_c, v_c = up_kv(ckv_c)
    kn_all = jnp.concatenate([kn_c, kn_l], axis=1)
    kr_all = jnp.concatenate([kr_c, kr_l], axis=1)
    v_all = jnp.concatenate([v_c, v_l], axis=1)
    o_lat = sweep_query_blocks(lambda a, b: attend(a, b, kn_all, kr_all, v_all), qn_l, qr_l)
    o_lat = o_lat.reshape(B, n, MLA_HEADS * MLA_V)
    o_ctx = None
    if need_ctx:
        qn_c, qr_c = up_q(cq_c)
        o_ctx = attend(qn_c, qr_c, kn_c, kr_c, v_c).reshape(B, -1, MLA_HEADS * MLA_V)
    return o_lat, o_ctx


def diff_branch(lat, ctx, lam_params, subln, lam_init, rope, need_ctx):
    q_l, k_l, v_l = lat
    q_c, k_c, v_c = ctx
    B, n = q_l.shape[:2]

    def split_heads(t):
        t = t.reshape(t.shape[0], t.shape[1], DIFF_HEADS, 2, DIFF_QK)
        return t[..., 0, :], t[..., 1, :]

    def vheads(t):
        return t.reshape(t.shape[0], t.shape[1], DIFF_HEADS, DIFF_V)

    lp = lam_params.astype(jnp.float32)
    lam = jnp.exp(jnp.sum(lp[0] * lp[1])) - jnp.exp(jnp.sum(lp[2] * lp[3])) + lam_init

    def attend(q1, q2, k1, k2, v):
        s1 = jnp.einsum('bqhd,bkhd->bhqk', q1, k1).astype(jnp.float32) * DIFF_SCALE
        s2 = jnp.einsum('bqhd,bkhd->bhqk', q2, k2).astype(jnp.float32) * DIFF_SCALE
        p = jax.nn.softmax(s1, axis=-1) - lam * jax.nn.softmax(s2, axis=-1)
        return jnp.einsum('bhqk,bkhd->bqhd', p.astype(v.dtype), v)

    def finish(o):
        return (rmsnorm(o, subln) * (1 - lam_init)).reshape(o.shape[0], o.shape[1], DIFF_HEADS * DIFF_V)

    q1_l, q2_l = split_heads(q_l)
    k1_l, k2_l = split_heads(k_l)
    q1_l, q2_l, k1_l, k2_l = [rope2d(t, rope) for t in (q1_l, q2_l, k1_l, k2_l)]
    k1_c, k2_c = split_heads(k_c)
    vc = vheads(v_c)
    k1_all = jnp.concatenate([k1_c, k1_l], axis=1)
    k2_all = jnp.concatenate([k2_c, k2_l], axis=1)
    v_all = jnp.concatenate([vc, vheads(v_l)], axis=1)
    o_lat = finish(sweep_query_blocks(lambda a1, a2: attend(a1, a2, k1_all, k2_all, v_all), q1_l, q2_l))
    o_ctx = None
    if need_ctx:
        q1_c, q2_c = split_heads(q_c)
        o_ctx = finish(attend(q1_c, q2_c, k1_c, k2_c, vc))
    return o_lat, o_ctx


def window_branch(lat, ctx, sink, rope, need_ctx):
    q_l, k_l, v_l = lat
    q_c, k_c, v_c = ctx
    B, n = q_l.shape[:2]
    nb = n // WINDOW
    q = rope2d(q_l.reshape(B, n, WIN_HEADS, WIN_DIM), rope)
    k = rope2d(k_l.reshape(B, n, WIN_KV_HEADS, WIN_DIM), rope)
    v = v_l.reshape(B, n, WIN_KV_HEADS, WIN_DIM)
    kc = k_c.reshape(B, -1, WIN_KV_HEADS, WIN_DIM)
    vc = v_c.reshape(B, -1, WIN_KV_HEADS, WIN_DIM)
    sink_g = sink.astype(jnp.float32).reshape(WIN_KV_HEADS, WIN_GROUP)

    def banded(t):
        tp = jnp.pad(t, ((0, 0), (WINDOW, WINDOW), (0, 0), (0, 0))).reshape(B, nb + 2, WINDOW, WIN_KV_HEADS, WIN_DIM)
        return jnp.concatenate([tp[:, :-2], tp[:, 1:-1], tp[:, 2:]], axis=2)

    kb, vb = banded(k), banded(v)
    qg = q.reshape(B, nb, WINDOW, WIN_KV_HEADS, WIN_GROUP, WIN_DIM)
    blk = np.arange(nb)[:, None, None]
    qpos = blk * WINDOW + np.arange(WINDOW)[None, :, None]
    kpos = blk * WINDOW - WINDOW + np.arange(3 * WINDOW)[None, None, :]
    band = (kpos >= 0) & (kpos < n) & (np.abs(qpos - kpos) <= WINDOW)
    s_loc = jnp.einsum('bnqkgd,bnjkd->bnkgqj', qg, kb).astype(jnp.float32) * WIN_SCALE
    s_loc = jnp.where(band[None, :, None, None], s_loc, NEG_INF)
    s_ctx = jnp.einsum('bnqkgd,bjkd->bnkgqj', qg, kc).astype(jnp.float32) * WIN_SCALE
    s_sink = jnp.broadcast_to(sink_g[None, None, :, :, None, None], s_loc.shape[:-1] + (1,))
    p = jax.nn.softmax(jnp.concatenate([s_loc, s_ctx, s_sink], axis=-1), axis=-1).astype(v.dtype)
    n_loc = 3 * WINDOW
    n_ctx = kc.shape[1]
    o = (jnp.einsum('bnkgqj,bnjkd->bnqkgd', p[..., :n_loc], vb)
         + jnp.einsum('bnkgqj,bjkd->bnqkgd', p[..., n_loc:n_loc + n_ctx], vc))
    o_lat = o.reshape(B, n, WIN_HEADS * WIN_DIM)
    o_ctx = None
    if need_ctx:
        qcg = q_c.reshape(B, -1, WIN_KV_HEADS, WIN_GROUP, WIN_DIM)
        s = jnp.einsum('bqkgd,bjkd->bkgqj', qcg, kc).astype(jnp.float32) * WIN_SCALE
        s_sink_c = jnp.broadcast_to(sink_g[None, :, :, None, None], s.shape[:-1] + (1,))
        pc = jax.nn.softmax(jnp.concatenate([s, s_sink_c], axis=-1), axis=-1)[..., :-1].astype(v.dtype)
        o_ctx = jnp.einsum('bkgqj,bjkd->bqkgd', pc, vc).reshape(B, -1, WIN_HEADS * WIN_DIM)
    return o_lat, o_ctx


def neighborhood_branch(lat, ctx, rpb, need_ctx):
    q_l, k_l, v_l = lat
    q_c, k_c, v_c = ctx
    B, n = q_l.shape[:2]
    rows = n // GRID_W
    wr = min(NA_ROWS, rows)
    ncb = GRID_W // NA_COLS
    n_kcol = 2 * NA_COLS
    r = np.arange(rows)
    row_idx = np.clip(r - wr // 2, 0, rows - wr)[:, None] + np.arange(wr)[None, :]
    col0 = np.clip(np.arange(ncb) * NA_COLS - NA_COLS // 2, 0, GRID_W - n_kcol)
    col_idx = col0[:, None] + np.arange(n_kcol)[None, :]
    qcol = np.arange(ncb)[:, None] * NA_COLS + np.arange(NA_COLS)[None, :]
    cstart = np.clip(qcol - NA_COLS // 2, 0, GRID_W - NA_COLS)
    kcol = col_idx[:, None, :]
    in_win = (kcol >= cstart[..., None]) & (kcol < cstart[..., None] + NA_COLS)
    d_row = row_idx - r[:, None] + (NA_ROWS - 1)
    d_col = np.clip(kcol - qcol[..., None], -(NA_COLS - 1), NA_COLS - 1) + (NA_COLS - 1)
    bias = rpb.astype(jnp.float32)[:, d_row[:, None, None, :, None], d_col[None, :, :, None, :]]
    bias = jnp.where(in_win[None, None, :, :, None, :], bias, NEG_INF)
    bias = jnp.transpose(bias, (1, 2, 0, 3, 4, 5)).reshape(rows, ncb, NA_HEADS, NA_COLS, wr * n_kcol)

    q = q_l.reshape(B, rows, ncb, NA_COLS, NA_HEADS, NA_DIM)
    kgrid = k_l.reshape(B, rows, GRID_W, NA_HEADS, NA_DIM)
    vgrid = v_l.reshape(B, rows, GRID_W, NA_HEADS, NA_DIM)
    gr = row_idx[:, None, :, None]
    gc = col_idx[None, :, None, :]
    kg = kgrid[:, gr, gc]
    vg = vgrid[:, gr, gc]
    kcx = k_c.reshape(B, -1, NA_HEADS, NA_DIM)
    vcx = v_c.reshape(B, -1, NA_HEADS, NA_DIM)
    s_loc = jnp.einsum('brcqhd,brcwjhd->brchqwj', q, kg).astype(jnp.float32)
    s_loc = s_loc.reshape(B, rows, ncb, NA_HEADS, NA_COLS, wr * n_kcol) * NA_SCALE + bias[None]
    s_ctx = jnp.einsum('brcqhd,bjhd->brchqj', q, kcx).astype(jnp.float32) * NA_SCALE
    p = jax.nn.softmax(jnp.concatenate([s_loc, s_ctx], axis=-1), axis=-1).astype(v_l.dtype)
    n_loc = wr * n_kcol
    p_loc = p[..., :n_loc].reshape(B, rows, ncb, NA_HEADS, NA_COLS, wr, n_kcol)
    o = (jnp.einsum('brchqwj,brcwjhd->brcqhd', p_loc, vg)
         + jnp.einsum('brchqj,bjhd->brcqhd', p[..., n_loc:], vcx))
    o_lat = o.reshape(B, n, NA_HEADS * NA_DIM)
    o_ctx = None
    if need_ctx:
        qcx = q_c.reshape(B, -1, NA_HEADS, NA_DIM)
        o_ctx = dense_attention(qcx, kcx, vcx, NA_SCALE).reshape(B, -1, NA_HEADS * NA_DIM)
    return o_lat, o_ctx


def merge_branches(h, outs, w_gate, b_gate, w_branch):
    y = None
    off = 0
    for i, (o, width) in enumerate(zip(outs, BRANCH_WIDTHS)):
        g = jax.nn.sigmoid(h @ w_gate[:, i * D_MODEL:(i + 1) * D_MODEL] + b_gate[i * D_MODEL:(i + 1) * D_MODEL])
        term = g * (o @ w_branch[off:off + width])
        y = term if y is None else y + term
        off += width
    return y


def squared_relu_mlp(h, w1, w2):
    return jnp.square(jax.nn.relu(h @ w1)) @ w2


def lambda_init(layer):
    return 0.8 - 0.6 * math.exp(-0.3 * layer)


def setup_inputs(seed: int = 0) -> dict:
    key = jax.random.key(seed)
    ks = jax.random.split(key, 24)
    D = D_MODEL

    def nrm(k, shape, scale):
        return scale * jax.random.normal(k, shape, jnp.float32)

    return {
        'x': nrm(ks[0], (BATCH, SEQ, D), 1.0),
        'c': nrm(ks[1], (BATCH, D), 1.0),
        'ctx': nrm(ks[2], (BATCH, CTX_LEN, D), 1.0),
        'c_ctx': nrm(ks[3], (D,), 1.0),
        'w_ada': nrm(ks[4], (DEPTH, D, N_ADA * D), 0.5 * D ** -0.5),
        'b_ada': nrm(ks[5], (DEPTH, N_ADA * D), 0.02),
        'norm_mix': 1.0 + nrm(ks[6], (DEPTH, D), 0.02),
        'norm_ffn': 1.0 + nrm(ks[7], (DEPTH, D), 0.02),
        'w_in': nrm(ks[8], (DEPTH, D, IN_WIDTH), D ** -0.5),
        'mla_q_norm': 1.0 + nrm(ks[9], (DEPTH, MLA_Q_RANK), 0.02),
        'mla_kv_norm': 1.0 + nrm(ks[10], (DEPTH, MLA_KV_RANK), 0.02),
        'w_uq': nrm(ks[11], (DEPTH, MLA_Q_RANK, MLA_HEADS * (MLA_NOPE + MLA_ROPE)), MLA_Q_RANK ** -0.5),
        'w_ukv': nrm(ks[12], (DEPTH, MLA_KV_RANK, MLA_HEADS * (MLA_NOPE + MLA_V)), MLA_KV_RANK ** -0.5),
        'diff_lambda': nrm(ks[13], (DEPTH, 4, DIFF_QK), 0.1),
        'diff_subln': 1.0 + nrm(ks[14], (DEPTH, DIFF_V), 0.02),
        'win_sink': nrm(ks[15], (DEPTH, WIN_HEADS), 0.5),
        'na_rpb': nrm(ks[16], (DEPTH, NA_HEADS, 2 * NA_ROWS - 1, 2 * NA_COLS - 1), 0.1),
        'w_gate': nrm(ks[17], (DEPTH, D, N_BRANCH * D), D ** -0.5),
        'b_gate': nrm(ks[18], (DEPTH, N_BRANCH * D), 0.02),
        'w_branch': nrm(ks[19], (DEPTH, MIX_WIDTH, D), (MIX_WIDTH // N_BRANCH) ** -0.5),
        'w_out': nrm(ks[20], (DEPTH, D, D), D ** -0.5),
        'w_ff1': nrm(ks[21], (DEPTH, D, FFN_HIDDEN), D ** -0.5),
        'w_ff2': nrm(ks[22], (DEPTH, FFN_HIDDEN, D), FFN_HIDDEN ** -0.5),
        'final_norm': 1.0 + nrm(ks[23], (D,), 0.02),
    }


def reference(x, c, ctx, c_ctx, w_ada, b_ada, norm_mix, norm_ffn, w_in, mla_q_norm, mla_kv_norm,
              w_uq, w_ukv, diff_lambda, diff_subln, win_sink, na_rpb, w_gate, b_gate, w_branch,
              w_out, w_ff1, w_ff2, final_norm):
    n_lat = x.shape[1]
    rope_mla = axial_rope_tables(n_lat, MLA_ROPE)
    rope_diff = axial_rope_tables(n_lat, DIFF_QK)
    rope_win = axial_rope_tables(n_lat, WIN_DIM)
    xc = ctx
    for l in range(DEPTH):
        need_ctx = l < DEPTH - 1
        mod_lat = jnp.split((jax.nn.silu(c) @ w_ada[l] + b_ada[l])[:, None, :], N_ADA, axis=-1)
        mod_ctx = jnp.split(jax.nn.silu(c_ctx) @ w_ada[l] + b_ada[l], N_ADA, axis=-1)
        h_lat = adaln(x, norm_mix[l], mod_lat[0], mod_lat[1])
        h_ctx = adaln(xc, norm_mix[l], mod_ctx[0], mod_ctx[1])
        p_lat = split_columns(h_lat @ w_in[l])
        p_ctx = split_columns(h_ctx @ w_in[l])
        oa_l, oa_c = mla_branch(p_lat[0:3], p_ctx[0:3], mla_q_norm[l], mla_kv_norm[l], w_uq[l], w_ukv[l], rope_mla, need_ctx)
        ob_l, ob_c = diff_branch(p_lat[3:6], p_ctx[3:6], diff_lambda[l], diff_subln[l], lambda_init(l), rope_diff, need_ctx)
        oc_l, oc_c = window_branch(p_lat[6:9], p_ctx[6:9], win_sink[l], rope_win, need_ctx)
        od_l, od_c = neighborhood_branch(p_lat[9:12], p_ctx[9:12], na_rpb[l], need_ctx)
        mix_lat = merge_branches(h_lat, (oa_l, ob_l, oc_l, od_l), w_gate[l], b_gate[l], w_branch[l])
        x = x + mod_lat[2] * (mix_lat @ w_out[l])
        h = adaln(x, norm_ffn[l], mod_lat[3], mod_lat[4])
        x = x + mod_lat[5] * squared_relu_mlp(h, w_ff1[l], w_ff2[l])
        if need_ctx:
            mix_ctx = merge_branches(h_ctx, (oa_c, ob_c, oc_c, od_c), w_gate[l], b_gate[l], w_branch[l])
            xc = xc + mod_ctx[2] * (mix_ctx @ w_out[l])
            hc = adaln(xc, norm_ffn[l], mod_ctx[3], mod_ctx[4])
            xc = xc + mod_ctx[5] * squared_relu_mlp(hc, w_ff1[l], w_ff2[l])
    return rmsnorm(x, final_norm)
```

```cpp
#include <hip/hip_runtime.h>
#include <hip/hip_cooperative_groups.h>
#include <cstdio>
#include <cstdint>
namespace cg = cooperative_groups;

#define LAS __attribute__((address_space(3)))
#define GAS __attribute__((address_space(1)))
#define PG8_LAS __attribute__((address_space(3)))

typedef unsigned short bf16_t;
typedef short bf16x8 __attribute__((ext_vector_type(8)));
typedef float f32x4 __attribute__((ext_vector_type(4)));
typedef float f32x2 __attribute__((ext_vector_type(2)));
typedef unsigned u32x4 __attribute__((ext_vector_type(4)));
typedef unsigned u32x2 __attribute__((ext_vector_type(2)));

constexpr int DM = 1024, NBATCH = 8, SEQ = 2048, CTXL = 256, NLAT = NBATCH * SEQ, NCTX = NBATCH * CTXL, NTOK = NLAT + NCTX, FF = 4096;
constexpr int PW = 2560;
constexpr int QW = 1024;
constexpr int INW = 2464;
constexpr int PC_CQ = 0, PC_CKV = 256, PC_KR = 384, PC_DQ = 512, PC_DK = 768, PC_DV = 1024, PC_WQ = 1280, PC_WK = 1536, PC_WV = 1664, PC_NQ = 1792, PC_NK = 2048, PC_NV = 2304;
constexpr int UC_KV = 384;
constexpr float LOG2E = 1.4426950408889634f;
constexpr float MLA_SC = 0.10206207261596577f * LOG2E;
constexpr float DIFF_SC = 0.17677669529663687f * LOG2E;
constexpr float WIN_SC = 0.125f * LOG2E, NA_SC = 0.125f * LOG2E;
constexpr float EPS = 1e-6f;

enum { I_X = 0, I_C, I_CTX, I_CCTX, I_WADA, I_BADA, I_NMIX, I_NFFN, I_WIN, I_QNORM, I_KVNORM, I_WUQ, I_WUKV, I_DLAM, I_SUBLN, I_SINK, I_RPB, I_WGATE, I_BGATE, I_WBR, I_WOUT, I_FF1, I_FF2, I_FNORM };

constexpr size_t MiB = 1u << 20;
constexpr size_t CTL_ZERO_BYTES = 1 * MiB;
constexpr int CW_BAR = 4096;
constexpr size_t WS_SSQ = 64 * 1024;
constexpr size_t WS_MOD = 1 * MiB;
constexpr size_t WS_WIN = 4 * MiB, WS_WUP = 9 * MiB, WS_WGATE = 10 * MiB, WS_WBR = 18 * MiB, WS_WOUT = 20 * MiB, WS_WFF1 = 22 * MiB, WS_WFF2 = 30 * MiB;
constexpr size_t WS_XC = 38 * MiB, WS_H1 = 46 * MiB, WS_BIG = 82 * MiB;
static_assert(WS_SSQ + (size_t)4 * NTOK * 4 <= CTL_ZERO_BYTES, "ssq inside memset region");

constexpr int NWAVES = 8;
constexpr int RING_BYTES = 131072;
constexpr int MISC_OFF = RING_BYTES + 320;
constexpr int LDS_BYTES = 147456;

__device__ const float ROPE_COS32[512] = {1.0f,1.0f,1.0f,1.0f,1.0f,1.0f,1.0f,1.0f,0.540302277f,0.950415254f,0.995004177f,0.999500036f,0.999949992f,0.999994993f,0.999999523f,0.99999994f,-0.416146845f,0.806578398f,0.980066597f,0.998000681f,0.999800026f,0.999979973f,0.999997973f,0.999999821f,-0.989992499f,0.582753599f,0.955336511f,0.995503366f,0.999550045f,0.999954998f,0.99999553f,0.999999523f,-0.653643608f,0.301137477f,0.921060979f,0.992010653f,0.999200106f,0.999920011f,0.999992013f,0.999999225f,0.2836622f,-0.0103423186f,0.87758255f,0.987526f,0.998750269f,0.999875009f,0.999987483f,0.999998748f,0.960170269f,-0.32079646f,0.825335622f,0.982053936f,0.998200536f,0.999819994f,0.999981999f,0.999998212f,0.753902256f,-0.599437416f,0.764842212f,0.975599885f,0.997551024f,0.999755025f,0.999975502f,0.999997556f,-0.145500034f,-0.818632483f,0.696706712f,0.968170285f,0.996801734f,0.999680042f,0.999967992f,0.999996781f,-0.91113025f,-0.956644177f,0.621609986f,0.959772646f,0.995952725f,0.999595046f,0.999959528f,0.999995947f,-0.839071512f,-0.999786079f,0.540302277f,0.950415254f,0.995004177f,0.999500036f,0.999949992f,0.999994993f,0.00442569796f,-0.943779707f,0.453596115f,0.940107584f,0.993956089f,0.999395072f,0.999939501f,0.99999392f,0.843853951f,-0.794179261f,0.362357765f,0.92885989f,0.99280864f,0.999280095f,0.999927998f,0.999992788f,0.907446802f,-0.565820515f,0.267498821f,0.916683376f,0.99156189f,0.999155104f,0.999915481f,0.999991536f,0.136737213f,-0.281349629f,0.169967145f,0.903590262f,0.990216017f,0.999020159f,0.99990201f,0.999990225f,-0.759687901f,0.0310225319f,0.070737198f,0.889593601f,0.988771081f,0.998875201f,0.999887526f,0.999988735f,-0.957659483f,0.340318203f,-0.029199522f,0.87470746f,0.987227261f,0.998720288f,0.999872029f,0.999987185f,-0.275163352f,0.615864694f,-0.1288445f,0.858946681f,0.985584795f,0.998555362f,0.999855518f,0.999985576f,0.660316706f,0.830336273f,-0.227202088f,0.842327058f,0.983843684f,0.998380423f,0.999837995f,0.999983788f,0.988704622f,0.962463796f,-0.323289573f,0.824865103f,0.982004225f,0.998195529f,0.999819517f,0.99998194f,0.408082068f,0.999144375f,-0.416146845f,0.806578398f,0.980066597f,0.998000681f,0.999800026f,0.999979973f,-0.547729254f,0.936740339f,-0.504846096f,0.787485182f,0.97803092f,0.99779582f,0.999779522f,0.999977946f,-0.99996084f,0.781440318f,-0.588501096f,0.76760453f,0.975897431f,0.997581005f,0.999758005f,0.999975801f,-0.53283304f,0.548645318f,-0.666276038f,0.746956348f,0.97366637f,0.997356176f,0.999735534f,0.999973536f,0.424179018f,0.26144141f,-0.737393737f,0.725561321f,0.971337974f,0.997121394f,0.99971199f,0.999971211f,0.991202831f,-0.051689472f,-0.801143587f,0.703440726f,0.968912423f,0.996876657f,0.999687493f,0.999968767f,0.64691931f,-0.359694332f,-0.856888771f,0.680616736f,0.966389954f,0.996621907f,0.999662042f,0.999966204f,-0.292138815f,-0.63202852f,-0.904072165f,0.657112241f,0.963770926f,0.996357203f,0.999635518f,0.999963522f,-0.962605894f,-0.841684759f,-0.942222357f,0.632950664f,0.961055458f,0.996082544f,0.99960804f,0.99996078f,-0.748057544f,-0.967871606f,-0.970958173f,0.608156204f,0.958243847f,0.995797932f,0.999579549f,0.999957979f,0.154251456f,-0.998075187f,-0.989992499f,0.582753599f,0.955336511f,0.995503366f,0.999550045f,0.999954998f,0.914742351f,-0.929300189f,-0.999135137f,0.556768298f,0.95233357f,0.995198846f,0.999519527f,0.999951959f,0.83422339f,-0.768367052f,-0.998294771f,0.53022635f,0.949235439f,0.994884372f,0.999488056f,0.9999488f,-0.0132767474f,-0.531235337f,-0.987479746f,0.503154159f,0.946042359f,0.994559944f,0.999455571f,0.999945521f,-0.848570287f,-0.241421327f,-0.966798186f,0.475578845f,0.942754686f,0.994225562f,0.999422073f,0.999942183f,-0.903692186f,0.072334297f,-0.93645668f,0.447528005f,0.939372718f,0.993881226f,0.999387562f,0.999938726f,-0.127963692f,0.378916562f,-0.896758437f,0.419029653f,0.935896814f,0.993526995f,0.999352098f,0.99993521f,0.765414059f,0.64792192f,-0.848100007f,0.39011234f,0.93232733f,0.993162811f,0.99931556f,0.999931574f,0.955073655f,0.852673173f,-0.790967703f,0.360804945f,0.928664625f,0.992788672f,0.999278069f,0.999927819f,0.266642928f,0.972865343f,-0.7259323f,0.331136763f,0.924909055f,0.99240464f,0.999239624f,0.999923944f,-0.666938066f,0.996578991f,-0.653643608f,0.301137477f,0.921060979f,0.992010653f,0.999200106f,0.999920011f,-0.987339258f,0.921462476f,-0.574823976f,0.270837069f,0.917120814f,0.991606772f,0.999159634f,0.999915957f,-0.399985313f,0.754965007f,-0.49026081f,0.240265846f,0.913088918f,0.991192937f,0.999118149f,0.999911785f,0.555113316f,0.513598084f,-0.400799185f,0.209454387f,0.908965766f,0.990769207f,0.999075651f,0.999907553f,0.999843299f,0.221297964f,-0.307332873f,0.178433478f,0.904751658f,0.990335584f,0.99903214f,0.999903202f,0.52532196f,-0.0929481685f,-0.210795805f,0.147234172f,0.90044713f,0.989892066f,0.998987675f,0.999898732f,-0.432177931f,-0.397976696f,-0.112152524f,0.115887627f,0.89605248f,0.989438653f,0.998942196f,0.999894202f,-0.992335498f,-0.663538098f,-0.0123886634f,0.084425211f,0.891568303f,0.988975346f,0.998895705f,0.999889553f,-0.640144348f,-0.863296807f,0.0874989852f,0.0528783761f,0.886994898f,0.988502085f,0.9988482f,0.999884784f,0.300592542f,-0.977442801f,0.186512366f,0.0212786663f,0.882332861f,0.98801899f,0.998799741f,0.999879956f,0.964965999f,-0.994656384f,0.2836622f,-0.0103423186f,0.87758255f,0.987526f,0.998750269f,0.999875009f,0.742154181f,-0.913230479f,0.377977729f,-0.0419529639f,0.872744501f,0.987023175f,0.998699784f,0.999869943f,-0.162990779f,-0.741239965f,0.468516678f,-0.0735216588f,0.86781919f,0.986510456f,0.998648286f,0.999864817f,-0.918282807f,-0.495741129f,0.554374337f,-0.105016835f,0.862807095f,0.985987842f,0.998595834f,0.999859571f,-0.829309821f,-0.20107992f,0.634692848f,-0.136407003f,0.857708693f,0.985455394f,0.998542368f,0.999854207f,0.0221267566f,0.113522276f,0.708669782f,-0.167660788f,0.852524519f,0.984913111f,0.99848789f,0.999848783f,0.853220105f,0.416866541f,0.775565863f,-0.19874692f,0.847255111f,0.984360933f,0.998432398f,0.99984318f,0.899866819f,0.67887038f,0.834712803f,-0.229634315f,0.841901004f,0.983798921f,0.998375952f,0.999837577f,0.119180135f,0.873551011f,0.885519505f,-0.260292083f,0.836462677f,0.983227074f,0.998318493f,0.999831796f,-0.771080196f,0.981602073f,0.927478433f,-0.290689617f,0.830940664f,0.982645452f,0.998260021f,0.999825954f,-0.952412963f,0.992308259f,0.960170269f,-0.32079646f,0.825335622f,0.982053936f,0.998200536f,0.999819994f,-0.258101642f,0.904607713f,0.98326844f,-0.35058254f,0.819648027f,0.981452644f,0.998140097f,0.999813974f,0.673507154f,0.727197766f,0.996542096f,-0.380018055f,0.813878477f,0.980841517f,0.998078644f,0.999807835f,0.985896587f,0.47767204f,0.999858618f,-0.409073591f,0.808027506f,0.980220556f,0.998016179f,0.999801576f};
__device__ const float ROPE_SIN32[512] = {0.0f,0.0f,0.0f,0.0f,0.0f,0.0f,0.0f,0.0f,0.841470957f,0.310983598f,0.099833414f,0.0316175073f,0.00999983307f,0.00316227227f,0.000999999815f,0.000316227757f,0.909297407f,0.591127098f,0.198669329f,0.0632033944f,0.0199986659f,0.00632451335f,0.0019999987f,0.000632455514f,0.141120002f,0.812648892f,0.295520216f,0.0947260931f,0.029995501f,0.00948669109f,0.0029999956f,0.000948683184f,-0.756802499f,0.953580737f,0.389418334f,0.126154065f,0.0399893336f,0.0126487734f,0.00399998948f,0.00126491068f,-0.958924294f,0.999946535f,0.47942555f,0.157455891f,0.0499791689f,0.0158107299f,0.0049999794f,0.00158113812f,-0.279415488f,0.947148144f,0.564642489f,0.188600287f,0.0599640049f,0.0189725272f,0.0059999642f,0.00189736544f,0.656986594f,0.800421655f,0.64421767f,0.219556093f,0.0699428469f,0.0221341364f,0.00699994294f,0.00221359264f,0.989358246f,0.574317753f,0.717356086f,0.250292361f,0.0799146965f,0.0252955221f,0.0079999147f,0.0025298195f,0.412118495f,0.29125911f,0.783326924f,0.280778348f,0.0898785517f,0.0284566563f,0.00899987854f,0.00284604612f,-0.54402113f,-0.0206835307f,0.841470957f,0.310983598f,0.099833414f,0.0316175073f,0.00999983307f,0.00316227227f,-0.999990225f,-0.330575019f,0.891207337f,0.340877861f,0.1097783f,0.0347780399f,0.0109997783f,0.00347849843f,-0.536572933f,-0.607683539f,0.932039082f,0.370431304f,0.119712204f,0.037938226f,0.0119997123f,0.00379472412f,0.420167029f,-0.824528456f,0.963558197f,0.399614334f,0.129634142f,0.0410980321f,0.0129996343f,0.00411094958f,0.990607381f,-0.959605336f,0.985449731f,0.428397804f,0.139543116f,0.0442574248f,0.0139995422f,0.00442717411f,0.650287867f,-0.999518692f,0.997494996f,0.456752867f,0.149438128f,0.0474163778f,0.0149994371f,0.00474339863f,-0.287903309f,-0.940310359f,0.999573588f,0.484651268f,0.159318209f,0.0505748577f,0.0159993172f,0.00505962269f,-0.961397469f,-0.78785193f,0.991664827f,0.512064993f,0.169182345f,0.053732831f,0.0169991814f,0.00537584629f,-0.750987232f,-0.557262719f,0.973847628f,0.538966775f,0.179029569f,0.0568902642f,0.0179990288f,0.00569206895f,0.149877205f,-0.271410018f,0.946300089f,0.565329552f,0.188858896f,0.060047131f,0.0189988576f,0.00600829162f,0.912945271f,0.0413582139f,0.909297407f,0.591127098f,0.198669329f,0.0632033944f,0.0199986659f,0.00632451335f,0.836655617f,0.350024998f,0.863209367f,0.616333604f,0.208459899f,0.0663590282f,0.0209984574f,0.00664073415f,-0.00885130931f,0.623979986f,0.808496416f,0.640923738f,0.218229622f,0.0695139989f,0.0219982248f,0.00695695495f,-0.846220434f,0.836055219f,0.745705187f,0.664873064f,0.227977529f,0.0726682767f,0.0229979716f,0.00727317436f,-0.905578375f,0.965219319f,0.6754632f,0.688157558f,0.237702623f,0.0758218244f,0.0239976961f,0.0075893933f,-0.132351756f,0.998663187f,0.598472118f,0.710753918f,0.247403964f,0.0789746195f,0.0249973964f,0.00790561177f,0.76255846f,0.933070183f,0.51550138f,0.732639611f,0.257080555f,0.0821266174f,0.0259970706f,0.00822182931f,0.956375957f,0.77494514f,0.427379876f,0.753792763f,0.266731441f,0.0852777958f,0.0269967187f,0.00853804592f,0.270905793f,0.539969206f,0.334988147f,0.774192154f,0.276355654f,0.0884281248f,0.0279963408f,0.0088542616f,-0.663633883f,0.251444817f,0.239249334f,0.793817401f,0.28595221f,0.0915775672f,0.0289959349f,0.00917047635f,-0.988031626f,-0.0620152019f,0.141120002f,0.812648892f,0.295520216f,0.0947260931f,0.029995501f,0.00948669109f,-0.404037654f,-0.369325221f,0.0415806621f,0.830667794f,0.305058628f,0.0978736728f,0.0309950355f,0.00980290398f,0.551426709f,-0.640009463f,-0.0583741441f,0.847856164f,0.314566553f,0.101020269f,0.0319945402f,0.0101191159f,0.999911845f,-0.847224295f,-0.157745689f,0.864196718f,0.324043036f,0.10416586f,0.0329940096f,0.010435327f,0.529082716f,-0.97042042f,-0.255541116f,0.879673123f,0.333487093f,0.107310407f,0.0339934491f,0.010751537f,-0.428182662f,-0.997380435f,-0.350783229f,0.894269943f,0.342897803f,0.110453889f,0.034992855f,0.0110677462f,-0.991778851f,-0.925430834f,-0.44252044f,0.907972574f,0.352274239f,0.113596253f,0.0359922238f,0.0113839535f,-0.643538117f,-0.761706769f,-0.529836118f,0.920767248f,0.361615419f,0.116737492f,0.036991559f,0.0117001608f,0.296368569f,-0.522444665f,-0.611857891f,0.932641327f,0.370920479f,0.119877562f,0.0379908569f,0.0120163662f,0.963795364f,-0.231372029f,-0.687766135f,0.943582773f,0.380188406f,0.123016424f,0.0389901139f,0.0123325698f,0.745113134f,0.0826456547f,-0.756802499f,0.953580737f,0.389418334f,0.126154065f,0.0399893336f,0.0126487734f,-0.158622667f,0.388467401f,-0.818277121f,0.962625206f,0.39860934f,0.129290447f,0.0409885123f,0.0129649751f,-0.916521549f,0.655765057f,-0.871575773f,0.970707119f,0.407760441f,0.132425532f,0.0419876538f,0.0132811759f,-0.831774771f,0.858030856f,-0.916165948f,0.977818429f,0.416870803f,0.135559291f,0.0429867506f,0.0135973748f,0.0177019257f,0.975206256f,-0.951602101f,0.983951986f,0.425939471f,0.138691694f,0.0439858027f,0.0139135728f,0.850903511f,0.995670974f,-0.977530122f,0.989101648f,0.434965521f,0.141822711f,0.0449848138f,0.0142297689f,0.901788354f,0.917395532f,-0.993691027f,0.993262351f,0.44394812f,0.144952312f,0.0459837802f,0.0145459641f,0.123573124f,0.748142481f,-0.999923229f,0.996429801f,0.452886283f,0.148080453f,0.0469826981f,0.0148621574f,-0.768254638f,0.504696608f,-0.99616462f,0.99860096f,0.461779177f,0.151207134f,0.0479815714f,0.0151783498f,-0.953752637f,0.211200237f,-0.982452631f,0.999773562f,0.470625877f,0.15433228f,0.0489803925f,0.0154945403f,-0.262374848f,-0.103240743f,-0.958924294f,0.999946535f,0.47942555f,0.157455891f,0.0499791689f,0.0158107299f,0.670229197f,-0.407443404f,-0.925814688f,0.99911958f,0.48817724f,0.160577938f,0.0509778932f,0.0161269177f,0.986627579f,-0.671240151f,-0.88345468f,0.997293591f,0.496880144f,0.163698375f,0.051976569f,0.0164431036f,0.395925164f,-0.868470371f,-0.832267463f,0.994470417f,0.505533338f,0.166817173f,0.0529751889f,0.0167592876f,-0.558789074f,-0.979574859f,-0.772764504f,0.990652859f,0.514136016f,0.169934288f,0.0539737605f,0.0170754697f,-0.999755144f,-0.993535459f,-0.705540299f,0.985844731f,0.522687256f,0.173049718f,0.0549722761f,0.01739165f,-0.521551013f,-0.908967733f,-0.631266654f,0.980050862f,0.531186223f,0.17616342f,0.0559707358f,0.0177078284f,0.436164767f,-0.734258175f,-0.550685525f,0.973276973f,0.539632022f,0.179275364f,0.0569691397f,0.0180240069f,0.992872655f,-0.486732632f,-0.464602172f,0.965529919f,0.548023939f,0.182385504f,0.0579674877f,0.0183401816f,0.636738002f,-0.190938085f,-0.373876661f,0.956817389f,0.55636102f,0.185493827f,0.0589657761f,0.0186563563f,-0.304810613f,0.123791665f,-0.279415488f,0.947148144f,0.564642489f,0.188600287f,0.0599640049f,0.0189725272f,-0.966117799f,0.426245064f,-0.182162508f,0.936531842f,0.572867453f,0.191704869f,0.0609621778f,0.0192886982f,-0.739180684f,0.68642801f,-0.0830894038f,0.924979091f,0.581035137f,0.194807529f,0.0619602874f,0.0196048655f,0.167355701f,0.878538251f,0.0168139003f,0.912501395f,0.589144766f,0.197908238f,0.0629583374f,0.0199210308f};
__device__ const float ROPE_COS64[1024] = {1.0f,1.0f,1.0f,1.0f,1.0f,1.0f,1.0f,1.0f,1.0f,1.0f,1.0f,1.0f,1.0f,1.0f,1.0f,1.0f,0.540302277f,0.846009135f,0.950415254f,0.98423022f,0.995004177f,0.998419285f,0.999500036f,0.999841869f,0.999949992f,0.999984205f,0.999994993f,0.999998391f,0.999999523f,0.999999821f,0.99999994f,1.0f,-0.416146845f,0.431462824f,0.806578398f,0.937418282f,0.980066597f,0.993682086f,0.998000681f,0.999367595f,0.999800026f,0.999936759f,0.999979973f,0.999993682f,0.999997973f,0.999999344f,0.999999821f,0.99999994f,-0.989992499f,-0.115966141f,0.582753599f,0.861040652f,0.955336511f,0.985803485f,0.995503366f,0.998577297f,0.999550045f,0.999857724f,0.999954998f,0.999985754f,0.99999553f,0.999998569f,0.999999523f,0.999999881f,-0.653643608f,-0.627679646f,0.301137477f,0.757506192f,0.921060979f,0.974808276f,0.992010653f,0.997471273f,0.999200106f,0.999747038f,0.999920011f,0.999974728f,0.999992013f,0.999997497f,0.999999225f,0.999999762f,0.2836622f,-0.946079254f,-0.0103423186f,0.630080283f,0.87758255f,0.960731268f,0.987526f,0.996049762f,0.998750269f,0.999604762f,0.999875009f,0.999960482f,0.999987483f,0.999996066f,0.999998748f,0.999999583f,0.960170269f,-0.973103702f,-0.32079646f,0.482782006f,0.825335622f,0.943616986f,0.982053936f,0.9943133f,0.998200536f,0.999430835f,0.999819994f,0.999943078f,0.999981999f,0.999994338f,0.999998212f,0.999999404f,0.753902256f,-0.700429916f,-0.599437416f,0.320256978f,0.764842212f,0.923519433f,0.975599885f,0.992262423f,0.997551024f,0.999225318f,0.999755025f,0.999922514f,0.999975502f,0.999992251f,0.999997556f,0.999999225f,-0.145500034f,-0.212036505f,-0.818632483f,0.147631198f,0.696706712f,0.900502324f,0.968170285f,0.989897788f,0.996801734f,0.998988271f,0.999680042f,0.999898791f,0.999967992f,0.999989867f,0.999996781f,0.999998987f,-0.91113025f,0.341660321f,-0.956644177f,-0.0296507962f,0.621609986f,0.874638259f,0.959772646f,0.987220109f,0.995952725f,0.998719573f,0.999595046f,0.99987191f,0.999959528f,0.999987185f,0.999995947f,0.999998748f,-0.839071512f,0.790131986f,-0.999786079f,-0.205997616f,0.540302277f,0.846009135f,0.950415254f,0.98423022f,0.995004177f,0.998419285f,0.999500036f,0.999841869f,0.999949992f,0.999984205f,0.999994993f,0.999998391f,0.00442569796f,0.995257378f,-0.943779707f,-0.375847369f,0.453596115f,0.814705312f,0.940107584f,0.980929136f,0.993956089f,0.998087406f,0.999395072f,0.999808669f,0.999939501f,0.999980867f,0.99999392f,0.999998093f,0.843853951f,0.893861651f,-0.794179261f,-0.5338431f,0.362357765f,0.780825913f,0.92885989f,0.97731787f,0.99280864f,0.997723997f,0.999280095f,0.99977231f,0.999927998f,0.999977231f,0.999992788f,0.999997735f,0.907446802f,0.517172813f,-0.565820515f,-0.675001621f,0.267498821f,0.744477987f,0.916683376f,0.973397553f,0.99156189f,0.997329056f,0.999155104f,0.999732792f,0.999915481f,0.999973297f,0.999991536f,0.999997318f,0.136737213f,-0.0187958125f,-0.281349629f,-0.794870913f,0.169967145f,0.705776393f,0.903590262f,0.969169438f,0.990216017f,0.996902585f,0.999020159f,0.999690115f,0.99990201f,0.999969006f,0.999990225f,0.999996901f,-0.759687901f,-0.548975706f,0.0310225319f,-0.889670372f,0.070737198f,0.664843559f,0.889593601f,0.964634836f,0.988771081f,0.996444523f,0.998875201f,0.999644279f,0.999887526f,0.999964416f,0.999988735f,0.999996424f,-0.957659483f,-0.910081029f,0.340318203f,-0.95641005f,-0.029199522f,0.621808827f,0.87470746f,0.959795177f,0.987227261f,0.99595499f,0.998720288f,0.999595284f,0.999872029f,0.999959528f,0.999987185f,0.999995947f,-0.275163352f,-0.990898013f,0.615864694f,-0.99298501f,-0.1288445f,0.576808274f,0.858946681f,0.954652011f,0.985584795f,0.995433986f,0.998555362f,0.999543071f,0.999855518f,0.999954283f,0.999985576f,0.99999541f,0.660316706f,-0.766536474f,0.830336273f,-0.998241663f,-0.227202088f,0.529984236f,0.842327058f,0.949207008f,0.983843684f,0.994881511f,0.998380423f,0.999487758f,0.999837995f,0.9999488f,0.999983788f,0.999994874f,0.988704622f,-0.30609566f,0.962463796f,-0.972014248f,-0.323289573f,0.481484622f,0.824865103f,0.943461835f,0.982004225f,0.994297504f,0.998195529f,0.999429286f,0.999819517f,0.999942899f,0.99998194f,0.999994278f,0.408082068f,0.248617053f,0.999144375f,-0.91512996f,-0.416146845f,0.431462824f,0.806578398f,0.937418282f,0.980066597f,0.993682086f,0.998000681f,0.999367595f,0.999800026f,0.999936759f,0.999979973f,0.999993682f,-0.547729254f,0.726760209f,0.936740339f,-0.829382896f,-0.504846096f,0.380077004f,0.787485182f,0.931078374f,0.97803092f,0.993035257f,0.99779582f,0.999302804f,0.999779522f,0.999930263f,0.999977946f,0.999993026f,-0.99996084f,0.981074512f,0.781440318f,-0.7174775f,-0.588501096f,0.327489585f,0.76760453f,0.92444396f,0.975897431f,0.992357016f,0.997581005f,0.999234855f,0.999758005f,0.999923468f,0.999975801f,0.999992371f,-0.53283304f,0.933235705f,0.548645318f,-0.582943201f,-0.666276038f,0.273866832f,0.746956348f,0.917517304f,0.97366637f,0.991647422f,0.997356176f,0.999163687f,0.999735534f,0.999916375f,0.999973536f,0.999991655f,0.424179018f,0.597977281f,0.26144141f,-0.430023134f,-0.737393737f,0.219378248f,0.725561321f,0.910300434f,0.971337974f,0.990906477f,0.997121394f,0.99908942f,0.99971199f,0.999908924f,0.999971211f,0.99999088f,0.991202831f,0.0785527974f,-0.051689472f,-0.263540328f,-0.801143587f,0.164196119f,0.703440726f,0.902795732f,0.968912423f,0.99013412f,0.996876657f,0.999011934f,0.999687493f,0.999901175f,0.999968767f,0.999990106f,0.64691931f,-0.465064526f,-0.359694332f,-0.0887456089f,-0.856888771f,0.108494893f,0.680616736f,0.895005584f,0.966389954f,0.98933053f,0.996621907f,0.998931348f,0.999662042f,0.999893129f,0.999966204f,0.999989331f,-0.292138815f,-0.865450501f,-0.63202852f,0.088848114f,-0.904072165f,0.0524506681f,0.657112241f,0.886932373f,0.963770926f,0.988495648f,0.996357203f,0.998847544f,0.999635518f,0.999884725f,0.999963522f,0.999988496f,-0.962605894f,-0.999293447f,-0.841684759f,0.263639599f,-0.942222357f,-0.00375937484f,0.632950664f,0.878578722f,0.961055458f,0.987629473f,0.996082544f,0.998760641f,0.99960804f,0.999876022f,0.99996078f,0.999987602f,-0.748057544f,-0.825372219f,-0.967871606f,0.430116028f,-0.970958173f,-0.0599575341f,0.608156204f,0.869947255f,0.958243847f,0.986732066f,0.995797932f,0.998670578f,0.999579549f,0.999867022f,0.999957979f,0.999986708f,0.154251456f,-0.397251397f,-0.998075187f,0.583026826f,-0.989992499f,-0.115966141f,0.582753599f,0.861040652f,0.955336511f,0.985803485f,0.995503366f,0.998577297f,0.999550045f,0.999857724f,0.999954998f,0.999985754f,0.914742351f,0.153215602f,-0.929300189f,0.717549205f,-0.999135137f,-0.171608135f,0.556768298f,0.851861775f,0.95233357f,0.984843671f,0.995198846f,0.998480916f,0.999519527f,0.999848068f,0.999951959f,0.999984801f,0.83422339f,0.656494975f,-0.768367052f,0.829440415f,-0.998294771f,-0.226707578f,0.53022635f,0.842413545f,0.949235439f,0.983852804f,0.994884372f,0.998381376f,0.999488056f,0.999838114f,0.9999488f,0.999983788f,-0.0132767474f,0.957585931f,-0.531235337f,0.915171444f,-0.987479746f,-0.281090319f,0.503154159f,0.832698941f,0.946042359f,0.982830763f,0.994559944f,0.998278618f,0.999455571f,0.999827802f,0.999945521f,0.999982774f,-0.848570287f,0.963757813f,-0.241421327f,0.972038448f,-0.966798186f,-0.334584415f,0.475578845f,0.822721004f,0.942754686f,0.981777668f,0.994225562f,0.99817276f,0.999422073f,0.999817252f,0.999942183f,0.999981701f,-0.903692186f,0.673109829f,0.072334297f,0.998247743f,-0.93645668f,-0.387020707f,0.447528005f,0.812482893f,0.939372718f,0.980693519f,0.993881226f,0.998063743f,0.999387562f,0.999806345f,0.999938726f,0.999980628f,-0.127963692f,0.175156325f,0.378916562f,0.992972851f,-0.896758437f,-0.438233495f,0.419029653f,0.801987886f,0.935896814f,0.979578316f,0.993526995f,0.997951567f,0.999352098f,0.999795079f,0.99993521f,0.999979496f,0.765414059f,-0.376742154f,0.64792192f,0.95638001f,-0.848100007f,-0.488060802f,0.39011234f,0.791239262f,0.93232733f,0.978432178f,0.993162811f,0.997836173f,0.99931556f,0.999783576f,0.999931574f,0.999978364f,0.955073655f,-0.812610924f,0.852673173f,0.889623404f,-0.790967703f,-0.536345124f,0.360804945f,0.780240476f,0.928664625f,0.977255106f,0.992788672f,0.997717679f,0.999278069f,0.999771714f,0.999927819f,0.999977171f,0.266642928f,-0.998210311f,0.972865343f,0.794808507f,-0.7259323f,-0.582933843f,0.331136763f,0.768994868f,0.924909055f,0.976047099f,0.99240464f,0.997596025f,0.999239624f,0.999759495f,0.999923944f,0.999975979f,-0.666938066f,-0.876379132f,0.996578991f,0.674925685f,-0.653643608f,-0.627679646f,0.301137477f,0.757506192f,0.921060979f,0.974808276f,0.992010653f,0.997471273f,0.999200106f,0.999747038f,0.999920011f,0.999974728f,-0.987339258f,-0.484639138f,0.921462476f,0.533756077f,-0.574823976f,-0.670441091f,0.270837069f,0.745777905f,0.917120814f,0.973538578f,0.991606772f,0.997343302f,0.999159634f,0.999734223f,0.999915957f,0.999973416f,-0.399985313f,0.0563608743f,0.754965007f,0.375752002f,-0.49026081f,-0.711082935f,0.240265846f,0.733813822f,0.913088918f,0.972238123f,0.991192937f,0.997212172f,0.999118149f,0.99972111f,0.999911785f,0.999972105f,0.555113316f,0.580002785f,0.513598084f,0.205896914f,-0.400799185f,-0.74947679f,0.209454387f,0.721617699f,0.908965766f,0.970906913f,0.990769207f,0.997077882f,0.999075651f,0.999707639f,0.999907553f,0.999970794f,0.999843299f,0.925014377f,0.221297964f,0.0295479279f,-0.307332873f,-0.785501122f,0.178433478f,0.709193349f,0.904751658f,0.969545007f,0.990335584f,0.996940494f,0.99903214f,0.99969393f,0.999903202f,0.999969363f,0.52532196f,0.985138416f,-0.0929481685f,-0.147732988f,-0.210795805f,-0.819042206f,0.147234172f,0.696544766f,0.90044713f,0.968152463f,0.989892066f,0.996799886f,0.998987675f,0.999679863f,0.999898732f,0.999967992f,-0.432177931f,0.741857767f,-0.397976696f,-0.320354462f,-0.112152524f,-0.849993944f,0.115887627f,0.683675885f,0.89605248f,0.966729224f,0.989438653f,0.996656179f,0.998942196f,0.999665439f,0.999894202f,0.999966562f,-0.992335498f,0.270098448f,-0.663538098f,-0.482872128f,-0.0123886634f,-0.878258407f,0.084425211f,0.670590878f,0.891568303f,0.965275466f,0.988975346f,0.996509314f,0.998895705f,0.999650776f,0.999889553f,0.999965072f,-0.640144348f,-0.284846276f,-0.863296807f,-0.630160213f,0.0874989852f,-0.903746367f,0.0528783761f,0.657293797f,0.886994898f,0.963791192f,0.988502085f,0.996359289f,0.9988482f,0.999635756f,0.999884784f,0.999963582f,0.300592542f,-0.752063513f,-0.977442801f,-0.757573366f,0.186512366f,-0.926377177f,0.0212786663f,0.643788815f,0.882332861f,0.962276459f,0.98801899f,0.996206105f,0.998799741f,0.999620378f,0.999879956f,0.999962032f,0.964965999f,-0.987658918f,-0.994656384f,-0.861092985f,0.2836622f,-0.946079254f,-0.0103423186f,0.630080283f,0.87758255f,0.960731268f,0.987526f,0.996049762f,0.998750269f,0.999604762f,0.999875009f,0.999960482f,0.742154181f,-0.919073343f,-0.913230479f,-0.937454164f,0.377977729f,-0.96279037f,-0.0419529639f,0.616172552f,0.872744501f,0.959155679f,0.987023175f,0.99589026f,0.998699784f,0.999588788f,0.999869943f,0.999958873f,-0.162990779f,-0.56742996f,-0.741239965f,-0.984248459f,0.468516678f,-0.976457715f,-0.0735216588f,0.602069914f,0.86781919f,0.95754981f,0.986510456f,0.995727658f,0.998648286f,0.999572515f,0.999864817f,0.999957263f,-0.918282807f,-0.0410284549f,-0.495741129f,-1.0f,0.554374337f,-0.987038016f,-0.105016835f,0.587776899f,0.862807095f,0.955913603f,0.985987842f,0.995561838f,0.998595834f,0.999555886f,0.999859571f,0.999955595f,-0.829309821f,0.498009056f,-0.20107992f,-0.984212041f,0.634692848f,-0.994497836f,-0.136407003f,0.573298037f,0.857708693f,0.954247177f,0.985455394f,0.995392919f,0.998542368f,0.999538958f,0.999854207f,0.999953866f,0.0221267566f,0.88366884f,0.113522276f,-0.93738246f,0.708669782f,-0.998813629f,-0.167660788f,0.558637917f,0.852524519f,0.95255059f,0.984913111f,0.99522084f,0.99848789f,0.999521732f,0.999848783f,0.999952197f,0.853220105f,0.99717474f,0.416866541f,-0.860988319f,0.775565863f,-0.999971747f,-0.19874692f,0.543801129f,0.847255111f,0.950823903f,0.984360933f,0.995045662f,0.998432398f,0.999504209f,0.99984318f,0.999950409f,0.899866819f,0.803568959f,0.67887038f,-0.757438958f,0.834712803f,-0.997968495f,-0.229634315f,0.528792322f,0.841901004f,0.949067116f,0.983798921f,0.994867265f,0.998375952f,0.999486327f,0.999837577f,0.999948621f,0.119180135f,0.362478614f,0.873551011f,-0.630000412f,0.885519505f,-0.99281019f,-0.260292083f,0.513616383f,0.836462677f,0.947280347f,0.983227074f,0.994685769f,0.998318493f,0.999468148f,0.999831796f,0.999946833f,-0.771080196f,-0.190248564f,0.981602073f,-0.482691884f,0.927478433f,-0.984513164f,-0.290689617f,0.498277962f,0.830940664f,0.945463598f,0.982645452f,0.994501114f,0.998260021f,0.99944967f,0.999825954f,0.999944985f,-0.952412963f,-0.684382617f,0.992308259f,-0.320159495f,0.960170269f,-0.973103702f,-0.32079646f,0.482782006f,0.825335622f,0.943616986f,0.982053936f,0.9943133f,0.998200536f,0.999430835f,0.999819994f,0.999943078f,-0.258101642f,-0.967739344f,0.904607713f,-0.147529408f,0.98326844f,-0.958617806f,-0.35058254f,0.467133373f,0.819648027f,0.941740453f,0.981452644f,0.994122326f,0.998140097f,0.999411702f,0.999813974f,0.99994117f,0.673507154f,-0.953049958f,0.727197766f,0.0297536626f,0.996542096f,-0.941101313f,-0.380018055f,0.451337039f,0.813878477f,0.939834237f,0.980841517f,0.993928254f,0.998078644f,0.999392271f,0.999807835f,0.999939203f,0.985896587f,-0.644838572f,0.47767204f,0.206098318f,0.999858618f,-0.920609534f,-0.409073591f,0.435397953f,0.808027506f,0.937898219f,0.980220556f,0.993731022f,0.998016179f,0.999372482f,0.999801576f,0.999937236f};
__device__ const float ROPE_SIN64[1024] = {0.0f,0.0f,0.0f,0.0f,0.0f,0.0f,0.0f,0.0f,0.0f,0.0f,0.0f,0.0f,0.0f,0.0f,0.0f,0.0f,0.841470957f,0.533168435f,0.310983598f,0.176892191f,0.099833414f,0.0562044978f,0.0316175073f,0.0177818574f,0.00999983307f,0.00562338345f,0.00316227227f,0.0017782785f,0.000999999815f,0.000562341302f,0.000316227757f,0.00017782794f,0.909297407f,0.902130723f,0.591127098f,0.348205268f,0.198669329f,0.112231314f,0.0632033944f,0.0355580896f,0.0199986659f,0.011246589f,0.00632451335f,0.00355655141f,0.0019999987f,0.00112468237f,0.000632455514f,0.00035565588f,0.141120002f,0.993253171f,0.812648892f,0.50853616f,0.295520216f,0.167903304f,0.0947260931f,0.0533230789f,0.029995501f,0.0168694388f,0.00948669109f,0.00533481315f,0.0029999956f,0.00168702321f,0.000948683184f,0.000533483806f,-0.756802499f,0.778471768f,0.953580737f,0.652827978f,0.389418334f,0.223044485f,0.126154065f,0.0710712075f,0.0399893336f,0.0224917568f,0.0126487734f,0.00711305765f,0.00399998948f,0.00224936334f,0.00126491068f,0.000711311703f,-0.958924294f,0.323935211f,0.999946535f,0.776529968f,0.47942555f,0.277480543f,0.157455891f,0.0887968615f,0.0499791689f,0.0281133614f,0.0158107299f,0.00889127981f,0.0049999794f,0.0028117029f,0.00158113812f,0.000889139599f,-0.279415488f,-0.230367482f,0.947148144f,0.875740588f,0.564642489f,0.331039339f,0.188600287f,0.106494434f,0.0599640049f,0.0337340795f,0.0189725272f,0.0106694736f,0.0059999642f,0.00337404152f,0.00189736544f,0.0010669675f,0.656986594f,-0.713721156f,0.800421655f,0.947330713f,0.64421767f,0.383551568f,0.219556093f,0.124158338f,0.0699428469f,0.0393537283f,0.0221341364f,0.0124476347f,0.00699994294f,0.00393637922f,0.00221359264f,0.00124479528f,0.989358246f,-0.977261722f,0.574317753f,0.989042461f,0.717356086f,0.434851229f,0.250292361f,0.141782969f,0.0799146965f,0.0449721329f,0.0252955221f,0.0142257558f,0.0079999147f,0.00449871551f,0.0025298195f,0.00142262306f,0.412118495f,-0.939823508f,0.29125911f,0.999560297f,0.783326924f,0.484776139f,0.280778348f,0.159362778f,0.0898785517f,0.0505891144f,0.0284566563f,0.0160038322f,0.00899987854f,0.00506105041f,0.00284604612f,0.00160045084f,-0.54402113f,-0.612936735f,-0.0206835307f,0.97855252f,0.841470957f,0.533168435f,0.310983598f,0.176892191f,0.099833414f,0.0562044978f,0.0316175073f,0.0177818574f,0.00999983307f,0.00562338345f,0.00316227227f,0.0017782785f,-0.999990225f,-0.0972766578f,-0.330575019f,0.926681578f,0.891207337f,0.579875171f,0.340877861f,0.194365665f,0.1097783f,0.0618181042f,0.0347780399f,0.0195598267f,0.0109997783f,0.00618571509f,0.00347849843f,0.00195610616f,-0.536572933f,0.44834289f,-0.607683539f,0.845583558f,0.932039082f,0.624748647f,0.370431304f,0.211777672f,0.119712204f,0.0674297586f,0.037938226f,0.0213377327f,0.0119997123f,0.00674804486f,0.00379472412f,0.00213393359f,0.420167029f,0.855880976f,-0.824528456f,0.737816215f,0.963558197f,0.667647004f,0.399614334f,0.229122713f,0.129634142f,0.0730392784f,0.0410980321f,0.0231155735f,0.0129996343f,0.00731037231f,0.00411094958f,0.00231176126f,0.990607381f,0.999823332f,-0.959605336f,0.606778562f,0.985449731f,0.708434701f,0.428397804f,0.246395305f,0.139543116f,0.078646481f,0.0442574248f,0.0248933397f,0.0139995422f,0.00787269697f,0.00442717411f,0.00248958869f,0.650287867f,0.835838318f,-0.999518692f,0.456603318f,0.997494996f,0.746982634f,0.456752867f,0.263589978f,0.149438128f,0.0842512026f,0.0474163778f,0.0266710278f,0.0149994371f,0.00843502022f,0.00474339863f,0.00266741589f,-0.287903309f,0.41443032f,-0.940310359f,0.292027056f,0.999573588f,0.783169091f,0.484651268f,0.280701309f,0.159318209f,0.0898532644f,0.0505748577f,0.028448632f,0.0159993172f,0.00899733976f,0.00505962269f,0.00284524332f,-0.961397469f,-0.134614661f,-0.78785193f,0.118240394f,0.991664827f,0.81687957f,0.512064993f,0.29772386f,0.169182345f,0.09545248f,0.053732831f,0.0302261449f,0.0169991814f,0.00955965649f,0.00537584629f,0.00302307028f,-0.750987232f,-0.642200768f,-0.557262719f,-0.0592755191f,0.973847628f,0.8480075f,0.538966775f,0.314652264f,0.179029569f,0.101048678f,0.0568902642f,0.0320035629f,0.0179990288f,0.0101219714f,0.00569206895f,0.00320089748f,0.149877205f,-0.952000737f,-0.271410018f,-0.234921902f,0.946300089f,0.876454532f,0.565329552f,0.331481189f,0.188858896f,0.10664168f,0.060047131f,0.0337808803f,0.0189988576f,0.0106842816f,0.00600829162f,0.00337872445f,0.912945271f,-0.968601882f,0.0413582139f,-0.403158963f,0.909297407f,0.902130723f,0.591127098f,0.348205268f,0.198669329f,0.112231314f,0.0632033944f,0.0355580896f,0.0199986659f,0.011246589f,0.00632451335f,0.00355655141f,0.836655617f,-0.686891258f,0.350024998f,-0.558680594f,0.863209367f,0.924954832f,0.616333604f,0.364819258f,0.208459899f,0.117817394f,0.0663590282f,0.0373351872f,0.0209984574f,0.0118088936f,0.00664073415f,0.00373437814f,-0.00885130931f,-0.193630621f,0.623979986f,-0.696581662f,0.808496416f,0.944854796f,0.640923738f,0.381317884f,0.218229622f,0.123399749f,0.0695139989f,0.0391121693f,0.0219982248f,0.0123711936f,0.00695695495f,0.00391220488f,-0.846220434f,0.359264702f,0.836055219f,-0.812512934f,0.745705187f,0.961767614f,0.664873064f,0.397695929f,0.227977529f,0.128978208f,0.0726682767f,0.0408890247f,0.0229979716f,0.0129334899f,0.00727317436f,0.00409003114f,-0.905578375f,0.801513016f,0.965219319f,-0.902817845f,0.6754632f,0.97563988f,0.688157558f,0.413948208f,0.237702623f,0.134552568f,0.0758218244f,0.0426657498f,0.0239976961f,0.0134957824f,0.0075893933f,0.00426785741f,-0.132351756f,0.996909976f,0.998663187f,-0.964648366f,0.598472118f,0.986427724f,0.710753918f,0.430069596f,0.247403964f,0.140122697f,0.0789746195f,0.0444423407f,0.0249973964f,0.0140580703f,0.00790561177f,0.00444568368f,0.76255846f,0.885276794f,0.933070183f,-0.996054351f,0.51550138f,0.994096994f,0.732639611f,0.446054965f,0.257080555f,0.145688385f,0.0821266174f,0.0462187938f,0.0259970706f,0.0146203535f,0.00822182931f,0.00462350994f,0.956375957f,0.500994503f,0.77494514f,-0.996045172f,0.427379876f,0.99862349f,0.753792763f,0.46189931f,0.266731441f,0.151249468f,0.0852777958f,0.0479950979f,0.0269967187f,0.015182632f,0.00853804592f,0.00480133574f,0.270905793f,-0.0375849828f,0.539969206f,-0.964621246f,0.334988147f,0.999992907f,0.774192154f,0.477597594f,0.276355654f,0.156805769f,0.0884281248f,0.049771253f,0.0279963408f,0.0157449059f,0.0088542616f,0.00497916155f,-0.663633883f,-0.564588964f,0.251444817f,-0.902773619f,0.239249334f,0.998200953f,0.793817401f,0.49314484f,0.28595221f,0.162357107f,0.0915775672f,0.0515472479f,0.0289959349f,0.0163071752f,0.00917047635f,0.00515698735f,-0.988031626f,-0.917709827f,-0.0620152019f,-0.812452912f,0.141120002f,0.993253171f,0.812648892f,0.50853616f,0.295520216f,0.167903304f,0.0947260931f,0.0533230789f,0.029995501f,0.0168694388f,0.00948669109f,0.00533481315f,-0.404037654f,-0.988192797f,-0.369325221f,-0.696507812f,0.0415806621f,0.985165298f,0.830667794f,0.523766637f,0.305058628f,0.173444211f,0.0978736728f,0.055098746f,0.0309950355f,0.0174316987f,0.00980290398f,0.00551263802f,0.551426709f,-0.754330397f,-0.640009463f,-0.55859524f,-0.0583741441f,0.973962843f,0.847856164f,0.538831532f,0.314566553f,0.17897962f,0.101020269f,0.0568742342f,0.0319945402f,0.0179939512f,0.0101191159f,0.00569046335f,0.999911845f,-0.288147956f,-0.847224295f,-0.403064787f,-0.157745689f,0.959681332f,0.864196718f,0.553725958f,0.324043036f,0.184509367f,0.10416586f,0.0586495437f,0.0329940096f,0.0185561981f,0.010435327f,0.00586828822f,0.529082716f,0.266778797f,-0.97042042f,-0.234821871f,-0.255541116f,0.942365766f,0.879673123f,0.568445385f,0.333487093f,0.190033287f,0.107310407f,0.0604246706f,0.0339934491f,0.0191184394f,0.010751537f,0.00604611309f,-0.428182662f,0.739542544f,-0.997380435f,-0.0591727868f,-0.350783229f,0.92207104f,0.894269943f,0.582984984f,0.342897803f,0.195551187f,0.110453889f,0.0621996038f,0.034992855f,0.0196806751f,0.0110677462f,0.00622393796f,-0.991778851f,0.984540641f,-0.925430834f,0.118342586f,-0.44252044f,0.89886117f,0.907972574f,0.597340286f,0.352274239f,0.201062918f,0.113596253f,0.0639743432f,0.0359922238f,0.0202429052f,0.0113839535f,0.00640176237f,-0.643538117f,0.926318169f,-0.761706769f,0.292125493f,-0.529836118f,0.872809649f,0.920767248f,0.611506641f,0.361615419f,0.206568286f,0.116737492f,0.0657488778f,0.036991559f,0.0208051279f,0.0117001608f,0.0065795863f,0.296368569f,0.582806587f,-0.522444665f,0.456694871f,-0.611857891f,0.84399873f,0.932641327f,0.625479698f,0.370920479f,0.212067112f,0.119877562f,0.0675232038f,0.0379908569f,0.021367345f,0.0120163662f,0.00675741024f,0.963795364f,0.0598011911f,-0.231372029f,0.60686034f,-0.687766135f,0.81251961f,0.943582773f,0.639254928f,0.380188406f,0.217559248f,0.123016424f,0.0692973137f,0.0389901139f,0.0219295528f,0.0123325698f,0.00693523418f,0.745113134f,-0.481621891f,0.0826456547f,0.737885714f,-0.756802499f,0.778471768f,0.953580737f,0.652827978f,0.389418334f,0.223044485f,0.126154065f,0.0710712075f,0.0399893336f,0.0224917568f,0.0126487734f,0.00711305765f,-0.158622667f,-0.874714196f,0.388467401f,0.845638514f,-0.818277121f,0.74196279f,0.962625206f,0.666194677f,0.39860934f,0.228522688f,0.129290447f,0.0728448778f,0.0409885123f,0.0230539516f,0.0129649751f,0.00729088113f,-0.916521549f,-0.998410463f,0.655765057f,0.926720262f,-0.871575773f,0.703108132f,0.970707119f,0.679350615f,0.407760441f,0.233993649f,0.132425532f,0.0746183172f,0.0419876538f,0.0236161407f,0.0132811759f,0.00746870413f,-0.831774771f,-0.814614534f,0.858030856f,0.97857368f,-0.916165948f,0.662030637f,0.977818429f,0.692291796f,0.416870803f,0.23945722f,0.135559291f,0.0763915181f,0.0429867506f,0.0241783205f,0.0135973748f,0.00764652714f,0.0177019257f,-0.379932135f,0.975206256f,0.999563336f,-0.951602101f,0.618860185f,0.983951986f,0.70501405f,0.425939471f,0.24491322f,0.138691694f,0.0781644806f,0.0439858027f,0.0247404929f,0.0139135728f,0.00782434922f,0.850903511f,0.171762422f,0.995670974f,0.989027262f,-0.977530122f,0.57373327f,0.989101648f,0.717513323f,0.434965521f,0.250361472f,0.141822711f,0.0799371973f,0.0449848138f,0.0253026597f,0.0142297689f,0.00800217222f,0.901788354f,0.670557261f,0.917395532f,0.947297752f,-0.993691027f,0.526792467f,0.993262351f,0.72978574f,0.44394812f,0.255801797f,0.144952312f,0.0817096531f,0.0459837802f,0.0258648153f,0.0145459641f,0.0081799943f,0.123573124f,0.962832689f,0.748142481f,0.875690877f,-0.999923229f,0.47818628f,0.996429801f,0.741827369f,0.452886283f,0.261234045f,0.148080453f,0.0834818631f,0.0469826981f,0.0264269654f,0.0148621574f,0.00835781638f,-0.768254638f,0.958573222f,0.504696608f,0.776465118f,-0.99616462f,0.42806834f,0.99860096f,0.753634453f,0.461779177f,0.266658038f,0.151207134f,0.0852537975f,0.0479815714f,0.0269891061f,0.0151783498f,0.00853563752f,-0.953752637f,0.659090638f,0.211200237f,0.652750015f,-0.982452631f,0.376597077f,0.999773562f,0.765203178f,0.470625877f,0.272073597f,0.15433228f,0.087025471f,0.0489803925f,0.0275512375f,0.0154945403f,0.00871345866f,-0.262374848f,0.156620145f,-0.103240743f,0.508447528f,-0.958924294f,0.323935211f,0.999946535f,0.776529968f,0.47942555f,0.277480543f,0.157455891f,0.0887968615f,0.0499791689f,0.0281133614f,0.0158107299f,0.00889127981f,0.670229197f,-0.39408651f,-0.407443404f,0.348108798f,-0.925814688f,0.270249248f,0.99911958f,0.787611187f,0.48817724f,0.282878697f,0.160577938f,0.0905679762f,0.0509778932f,0.0286754761f,0.0161269177f,0.00906910095f,0.986627579f,-0.823421657f,-0.671240151f,0.176790893f,-0.88345468f,0.215708897f,0.997293591f,0.798443377f,0.496880144f,0.28826794f,0.163698375f,0.0923388004f,0.051976569f,0.0292375814f,0.0164431036f,0.00924692117f,0.395925164f,-0.999157965f,-0.868470371f,-0.00010291244f,-0.832267463f,0.160486609f,0.994470417f,0.809023023f,0.505533338f,0.293648034f,0.166817173f,0.0941093415f,0.0529751889f,0.0297996774f,0.0167592876f,0.00942474138f,-0.558789074f,-0.867171824f,-0.979574859f,-0.176993474f,-0.772764504f,0.104756944f,0.990652859f,0.819346905f,0.514136016f,0.29901886f,0.169934288f,0.0958795771f,0.0539737605f,0.0303617641f,0.0170754697f,0.00960256159f,-0.999755144f,-0.468112558f,-0.993535459f,-0.348301739f,-0.705540299f,0.0486961007f,0.985844731f,0.829411626f,0.522687256f,0.304380238f,0.173049718f,0.0976495072f,0.0549722761f,0.0309238415f,0.01739165f,0.00978038087f,-0.521551013f,0.0751168504f,-0.908967733f,-0.508624732f,-0.631266654f,-0.0075186966f,0.980050862f,0.839214146f,0.531186223f,0.30973199f,0.17616342f,0.0994191319f,0.0559707358f,0.0314859077f,0.0177078284f,0.00995820016f,0.436164767f,0.595211625f,-0.734258175f,-0.652905941f,-0.550685525f,-0.063709721f,0.973276973f,0.848751247f,0.539632022f,0.315073937f,0.179275364f,0.101188444f,0.0569691397f,0.0320479684f,0.0180240069f,0.0101360194f,0.992872655f,0.931992114f,-0.486732632f,-0.776594818f,-0.464602172f,-0.119699337f,0.965529919f,0.858019948f,0.548023939f,0.32040593f,0.182385504f,0.102957435f,0.0579674877f,0.0326100141f,0.0183401816f,0.0103138378f,0.636738002f,0.981735945f,-0.190938085f,-0.875790238f,-0.373876661f,-0.175310522f,0.956817389f,0.867017329f,0.55636102f,0.325727791f,0.185493827f,0.104726106f,0.0589657761f,0.0331720524f,0.0186563563f,0.0104916561f,-0.304810613f,0.729123056f,0.123791665f,-0.947363675f,-0.279415488f,-0.230367482f,0.947148144f,0.875740588f,0.564642489f,0.331039339f,0.188600287f,0.106494434f,0.0599640049f,0.0337340795f,0.0189725272f,0.0106694736f,-0.966117799f,0.251953512f,0.426245064f,-0.98905766f,-0.182162508f,-0.284696132f,0.936531842f,0.884186864f,0.572867453f,0.336340427f,0.191704869f,0.108262435f,0.0609621778f,0.0342960954f,0.0192886982f,0.0108472919f,-0.739180684f,-0.302813113f,0.68642801f,-0.999557257f,-0.0830894038f,-0.338124752f,0.924979091f,0.892353535f,0.581035137f,0.341630876f,0.194807529f,0.110030092f,0.0619602874f,0.0348581001f,0.0196048655f,0.0110251093f,0.167355701f,-0.764318824f,0.878538251f,-0.978531301f,0.0168139003f,-0.390484393f,0.912501395f,0.900238097f,0.589144766f,0.346910506f,0.197908238f,0.1117974f,0.0629583374f,0.0354200937f,0.0199210308f,0.0112029258f};


__device__ __forceinline__ unsigned cvt_pk_bf16(float lo, float hi) { unsigned r; asm volatile("v_cvt_pk_bf16_f32 %0, %1, %2" : "=v"(r) : "v"(lo), "v"(hi)); return r; }
__device__ __forceinline__ float bf_lo(unsigned u) { return __uint_as_float(u << 16); }
__device__ __forceinline__ float bf_hi(unsigned u) { return __uint_as_float(u & 0xffff0000u); }
__device__ __forceinline__ float bf1(bf16_t u) { return __uint_as_float((unsigned)u << 16); }
__device__ __forceinline__ float fast_exp2(float x) { return __builtin_amdgcn_exp2f(x); }
__device__ __forceinline__ float wave_sum(float v) {
#pragma unroll
    for (int o = 1; o < 64; o <<= 1) v += __shfl_xor(v, o);
    return v;
}
#define LDS_WAIT() asm volatile("s_waitcnt lgkmcnt(0)" ::: "memory")

#define XB_TMO      128
#define XB_XCNT(j)  (256  + 64 * (j))
#define XB_XSUB(j)  (1280 + 64 * (j))
#define XB_XGEN(j)  (2304 + 64 * (j))
#define XB_TOP      3328
#define XB_TOPGEN   3392
#define XCD_BAR_WORDS 3456
#define XB_SPIN_CAP (1u << 18)
__device__ __forceinline__ unsigned xb_ld(unsigned* p)              { return __hip_atomic_load(p, __ATOMIC_RELAXED, __HIP_MEMORY_SCOPE_AGENT); }
__device__ __forceinline__ unsigned xb_add(unsigned* p, unsigned v) { return __hip_atomic_fetch_add(p, v, __ATOMIC_RELAXED, __HIP_MEMORY_SCOPE_AGENT); }
__device__ __forceinline__ unsigned xb_xcc_id() { return (unsigned)__builtin_amdgcn_s_getreg((3 << 11) | 20) & 0xFu; }
#define XB_SPIN(cond, bar) do { unsigned _sp = 0; while (cond) { __builtin_amdgcn_s_sleep(1); \
    if ((++_sp & 255u) == 0u) { if (xb_ld(&(bar)[XB_TMO])) break; if (_sp > XB_SPIN_CAP) { atomicAdd(&(bar)[XB_TMO], 1u); break; } } } } while (0)
struct XcdBarrier { unsigned* bar; unsigned x; volatile LAS unsigned* st; };
__device__ __forceinline__ XcdBarrier xcd_barrier_post(unsigned* bar, volatile LAS unsigned* st) {
    XcdBarrier b; b.bar = bar; b.x = xb_xcc_id(); b.st = st;
    if (threadIdx.x == 0) (void)xb_add(&bar[XB_XCNT(b.x)], 1u);
    return b;
}
__device__ __forceinline__ void xcd_barrier_complete(unsigned* bar, unsigned x, unsigned& nloc, unsigned& nx) {
    const unsigned G = gridDim.x * gridDim.y * gridDim.z;
    unsigned sum, cnt, mine, sp = 0u;
    for (;;) {
        sum = 0u; cnt = 0u; mine = 0u;
#pragma unroll
        for (unsigned j = 0; j < 16; ++j) { const unsigned c = xb_ld(&bar[XB_XCNT(j)]); sum += c; cnt += (c > 0u) ? 1u : 0u; mine = (j == x) ? c : mine; }
        if (sum == G) break;
        __builtin_amdgcn_s_sleep(1);
        if ((++sp & 255u) == 0u) { if (xb_ld(&bar[XB_TMO])) break; if (sp > XB_SPIN_CAP) { atomicAdd(&bar[XB_TMO], 1u); break; } }
    }
    nloc = mine > 0u ? mine : 1u; nx = cnt > 0u ? cnt : 1u;
}
__device__ __forceinline__ void xcd_barrier(const XcdBarrier& b) {
    asm volatile("s_waitcnt vmcnt(0)" ::: "memory");
    __syncthreads();
    if (threadIdx.x == 0) {
        unsigned* bar = b.bar;
        __builtin_amdgcn_s_waitcnt(0);
        unsigned nloc = b.st[0], nx = b.st[1];
        if (nloc == 0u) { xcd_barrier_complete(bar, b.x, nloc, nx); b.st[0] = nloc; b.st[1] = nx; }
        const unsigned old = xb_add(&bar[XB_XSUB(b.x)], 1u);
        const unsigned gen = old / nloc;
        if (old + 1u == (gen + 1u) * nloc) {
            __builtin_amdgcn_fence(__ATOMIC_RELEASE, "agent");
            asm volatile("s_waitcnt vmcnt(0)" ::: "memory");
            const unsigned og = xb_add(&bar[XB_TOP], 1u);
            const unsigned tg = og / nx;
            if (og + 1u == (tg + 1u) * nx) xb_add(&bar[XB_TOPGEN], 1u);
            else XB_SPIN(xb_ld(&bar[XB_TOPGEN]) == tg, bar);
            __builtin_amdgcn_fence(__ATOMIC_ACQUIRE, "agent");
            xb_add(&bar[XB_XGEN(b.x)], 1u);
            asm volatile("s_waitcnt vmcnt(0)" ::: "memory");
        } else {
            XB_SPIN(xb_ld(&bar[XB_XGEN(b.x)]) == gen, bar);
            __builtin_amdgcn_fence(__ATOMIC_ACQUIRE, "agent");
            asm volatile("s_waitcnt vmcnt(0)" ::: "memory");
        }
    }
    __syncthreads();
}

namespace pg8 {
constexpr int BM = 256, BK = 64, HALF = 128, HTB = HALF * BK * 2, STAGE_BYTES = 8 * HTB, NXCD = 8, WGM = 8;
__host__ __device__ __forceinline__ int lds_byte(int r, int c) { const int st = (r >> 4) * 2 + (c >> 5), rr = r & 15, cc = c & 31, ob = rr * 64 + cc * 2; return st * 1024 + (ob ^ (((ob >> 9) & 1) << 5)); }
__host__ __device__ __forceinline__ void stage_rc(int b, int& R, int& C) { const int st = b / 1024, sb = b % 1024, swz = sb ^ (((sb >> 9) & 1) << 5); R = (st >> 1) * 16 + swz / 64; C = (st & 1) * 32 + (swz % 64) / 2; }
__host__ __device__ __forceinline__ int perm32(int rho) { const int n = rho >> 4, i = rho & 15; return 8 * (i >> 2) + 4 * n + (i & 3); }
struct Unit { int pm, pn; };
struct Prob {
    const char* A; const char* B; int nt, lda, ldb; size_t hstepB;
    size_t a_pm, a_pnhi; int a_sh;
    size_t b_pnlo, b_pnhi; int b_mask, b_sh;
    __device__ __forceinline__ const char* abase(const Unit& u) const { return A + (size_t)u.pm * a_pm + (size_t)(u.pn >> a_sh) * a_pnhi; }
    __device__ __forceinline__ const char* bbase(const Unit& u) const { return B + (size_t)(u.pn & b_mask) * b_pnlo + (size_t)(u.pn >> b_sh) * b_pnhi; }
};
__device__ __forceinline__ Prob plain_prob(const bf16_t* A, int lda, const bf16_t* Bt, int K) {
    Prob p; p.A = (const char*)A; p.B = (const char*)Bt; p.nt = K / BK; p.lda = lda; p.ldb = K; p.hstepB = (size_t)HALF * K * 2;
    p.a_pm = (size_t)BM * lda * 2; p.a_pnhi = 0; p.a_sh = 0; p.b_pnlo = (size_t)BM * K * 2; p.b_pnhi = 0; p.b_mask = ~0; p.b_sh = 0; return p;
}
struct StaticOrder {
    int nM, nN, nwg, G, c;
    __host__ __device__ void init(int nM_, int nN_, int G_, int c_) { nM = nM_; nN = nN_; nwg = nM * nN; G = G_; c = c_; }
    __host__ __device__ bool next(int i, Unit& u) const {
        const long L = (long)i * G + c; if (L >= nwg) return false;
        int wgid = (int)L; { const int q = nwg / NXCD, r = nwg % NXCD, xcd = wgid % NXCD, off = wgid / NXCD; wgid = (xcd < r ? xcd * (q + 1) : r * (q + 1) + (xcd - r) * q) + off; }
        const int nig = WGM * nN, gid = wgid / nig, fm = gid * WGM, gsz = (nM - fm) < WGM ? (nM - fm) : WGM;
        u.pm = fm + ((wgid % nig) % gsz); u.pn = (wgid % nig) / gsz; return true;
    }
    __device__ __forceinline__ void a_ready(const Unit&) const {}
    __device__ __forceinline__ void done(const Unit&) const {}
};
template <class Epi, class Prob, class Sched, bool ALIGN_EPI = false, bool SP2 = false>
__device__ __forceinline__ void gemm_phase(PG8_LAS unsigned char* lds, const Prob g, const Sched& S, const Epi& E) {
    int tid_raw = threadIdx.x; asm volatile("" : "+v"(tid_raw));
    const int tid = tid_raw, wid = __builtin_amdgcn_readfirstlane(tid >> 6), lane = tid & 63, wr = wid >> 2, wc = wid & 3, fr = lane & 15, fq = lane >> 4;
    const int nt = g.nt;
    unsigned voffA[2], voffB[2];
#pragma unroll
    for (int i = 0; i < 2; ++i) { int R, C; stage_rc(tid * 16 + i * 8192, R, C); const int Rb = Epi::brow(R);
        voffA[i] = (unsigned)(R * g.lda + C) * 2u; voffB[i] = (unsigned)(Rb * g.ldb + C) * 2u; }
    const size_t kstep = (size_t)(BK * 2);
    const size_t hstepA = (size_t)HALF * g.lda * 2, hstepB = g.hstepB;
    const unsigned ldsw = (unsigned)wid * 1024u;
    const int aoff = lds_byte(wr * 64 + fr, fq * 8), boff = lds_byte(wc * 32 + fr, fq * 8);
#define PG8_SA(b, h) (((b) * 2 + (h)) * HTB)
#define PG8_SB(b, h) ((4 + (b) * 2 + (h)) * HTB)
#define PG8_STAGE(bufoff, gbase, voff) do { _Pragma("unroll") for (int _i = 0; _i < 2; ++_i) \
        __builtin_amdgcn_global_load_lds((const unsigned*)((const char*)(gbase) + (voff)[_i]), (PG8_LAS unsigned*)(lds + (bufoff) + ldsw + _i * 8192), 16, 0, 0); } while (0)
#define PG8_LDA(dst, b, h) do { _Pragma("unroll") for (int m = 0; m < 4; ++m) _Pragma("unroll") for (int k = 0; k < 2; ++k) dst[m][k] = *(const PG8_LAS bf16x8*)(lds + PG8_SA(b, h) + aoff + m * 2048 + k * 1024); } while (0)
#define PG8_LDB(dst, b, h) do { _Pragma("unroll") for (int n = 0; n < 2; ++n) _Pragma("unroll") for (int k = 0; k < 2; ++k) dst[n][k] = *(const PG8_LAS bf16x8*)(lds + PG8_SB(b, h) + boff + n * 2048 + k * 1024); } while (0)
#define PG8_MMA(ai, bj, At, Bt) do { __builtin_amdgcn_s_setprio(1); _Pragma("unroll") for (int m = 0; m < 4; ++m) _Pragma("unroll") for (int n = 0; n < 2; ++n) _Pragma("unroll") for (int k = 0; k < 2; ++k) \
        acc[ai][bj][m][n] = __builtin_amdgcn_mfma_f32_16x16x32_bf16(Bt[n][k], At[m][k], acc[ai][bj][m][n], 0, 0, 0); __builtin_amdgcn_s_setprio(0); } while (0)
#define PG8_WAIT_V(n) asm volatile("s_waitcnt vmcnt(" #n ")" ::: "memory")
#define PG8_WAIT_L(n) asm volatile("s_waitcnt lgkmcnt(" #n ")" ::: "memory")
#define PG8_BAR __builtin_amdgcn_s_barrier()
#define PG8_SCHED __builtin_amdgcn_sched_barrier(0)
    Unit cur, nxt; int ui = 0;
    if (!S.next(0, cur)) return;
    f32x4 acc[2][2][4][2];
#pragma unroll
    for (int a = 0; a < 2; ++a)
#pragma unroll
        for (int b = 0; b < 2; ++b)
#pragma unroll
            for (int m = 0; m < 4; ++m)
#pragma unroll
                for (int n = 0; n < 2; ++n) acc[a][b][m][n] = (f32x4){0.f, 0.f, 0.f, 0.f};
    bf16x8 At[4][2], B0[2][2], B1[2][2];
    const char* cA = g.abase(cur); const char* cB = g.bbase(cur);
    S.a_ready(cur);
    if constexpr (SP2) {
        PG8_STAGE(PG8_SB(0, 0), cB, voffB); PG8_STAGE(PG8_SB(0, 1), cB + hstepB, voffB); PG8_STAGE(PG8_SA(0, 0), cA, voffA); PG8_STAGE(PG8_SA(0, 1), cA + hstepA, voffA);
        if (wr == 1) PG8_BAR;
        PG8_WAIT_V(2); PG8_BAR;
        PG8_STAGE(PG8_SB(1, 0), cB + kstep, voffB); PG8_STAGE(PG8_SA(1, 0), cA + kstep, voffA); PG8_STAGE(PG8_SB(1, 1), cB + hstepB + kstep, voffB);
        PG8_WAIT_V(6); PG8_BAR;
    } else {
        PG8_STAGE(PG8_SB(0, 0), cB, voffB); PG8_STAGE(PG8_SA(0, 0), cA, voffA); PG8_STAGE(PG8_SB(0, 1), cB + hstepB, voffB); PG8_STAGE(PG8_SA(0, 1), cA + hstepA, voffA);
        if (wr == 1) PG8_BAR;
        PG8_WAIT_V(4); PG8_BAR;
        PG8_STAGE(PG8_SB(1, 0), cB + kstep, voffB); PG8_STAGE(PG8_SA(1, 0), cA + kstep, voffA); PG8_STAGE(PG8_SB(1, 1), cB + hstepB + kstep, voffB);
        PG8_WAIT_V(6); PG8_BAR;
    }
    for (;;) {
        const bool has_next = S.next(ui + 1, nxt);
        const char* nA = has_next ? g.abase(nxt) : cA; const char* nB = has_next ? g.bbase(nxt) : cB;
        for (int t = 0; t < nt; t += 2) {
            const bool last = (t == nt - 2);
            const char* a1 = cA + (size_t)(t + 1) * kstep;
            const char* a2 = last ? nA : cA + (size_t)(t + 2) * kstep; const char* b2 = last ? nB : cB + (size_t)(t + 2) * kstep;
            const char* a3 = a2 + kstep; const char* b3 = b2 + kstep;
            if (last && has_next) S.a_ready(nxt);
            if constexpr (SP2) {
            PG8_LDB(B0, 0, 0); PG8_LDB(B1, 0, 1); PG8_SCHED; PG8_LDA(At, 0, 0); PG8_STAGE(PG8_SA(1, 1), a1 + hstepA, voffA);
            PG8_WAIT_V(8); PG8_WAIT_L(0); PG8_BAR; PG8_MMA(0, 0, At, B0); PG8_MMA(0, 1, At, B1); PG8_BAR; PG8_SCHED;
            PG8_LDA(At, 0, 1); PG8_STAGE(PG8_SB(0, 0), b2, voffB); PG8_STAGE(PG8_SB(0, 1), b2 + hstepB, voffB); PG8_STAGE(PG8_SA(0, 0), a2, voffA);
            PG8_WAIT_V(8); PG8_WAIT_L(0); PG8_BAR; PG8_MMA(1, 0, At, B0); PG8_MMA(1, 1, At, B1); PG8_BAR; PG8_SCHED;
            PG8_LDB(B0, 1, 0); PG8_LDB(B1, 1, 1); PG8_SCHED; PG8_LDA(At, 1, 0); PG8_STAGE(PG8_SA(0, 1), a2 + hstepA, voffA);
            PG8_WAIT_V(8); PG8_WAIT_L(0); PG8_BAR; PG8_MMA(0, 0, At, B0); PG8_MMA(0, 1, At, B1); PG8_BAR; PG8_SCHED;
            PG8_LDA(At, 1, 1); PG8_STAGE(PG8_SB(1, 0), b3, voffB); PG8_STAGE(PG8_SB(1, 1), b3 + hstepB, voffB); PG8_STAGE(PG8_SA(1, 0), a3, voffA);
            PG8_WAIT_V(8); PG8_WAIT_L(0); PG8_BAR; PG8_MMA(1, 0, At, B0); PG8_MMA(1, 1, At, B1); PG8_BAR; PG8_SCHED;
            } else {
            PG8_LDB(B0, 0, 0); PG8_SCHED; PG8_LDA(At, 0, 0); PG8_STAGE(PG8_SA(1, 1), a1 + hstepA, voffA);
            PG8_WAIT_L(8); PG8_BAR; PG8_WAIT_L(0); PG8_MMA(0, 0, At, B0); PG8_BAR; PG8_SCHED;
            PG8_LDB(B1, 0, 1); PG8_STAGE(PG8_SB(0, 0), b2, voffB);
            PG8_BAR; PG8_WAIT_L(0); PG8_MMA(0, 1, At, B1); PG8_BAR;
            PG8_LDA(At, 0, 1); PG8_STAGE(PG8_SA(0, 0), a2, voffA);
            PG8_BAR; PG8_WAIT_L(0); PG8_MMA(1, 0, At, B0); PG8_BAR; PG8_SCHED;
            PG8_STAGE(PG8_SB(0, 1), b2 + hstepB, voffB);
            PG8_WAIT_V(6); PG8_BAR; PG8_MMA(1, 1, At, B1); PG8_BAR;
            PG8_LDB(B0, 1, 0); PG8_SCHED; PG8_LDA(At, 1, 0); PG8_STAGE(PG8_SA(0, 1), a2 + hstepA, voffA);
            PG8_WAIT_L(8); PG8_BAR; PG8_WAIT_L(0); PG8_MMA(0, 0, At, B0); PG8_BAR; PG8_SCHED;
            PG8_LDB(B1, 1, 1); PG8_STAGE(PG8_SB(1, 0), b3, voffB);
            PG8_BAR; PG8_WAIT_L(0); PG8_MMA(0, 1, At, B1); PG8_BAR;
            PG8_LDA(At, 1, 1); PG8_STAGE(PG8_SA(1, 0), a3, voffA);
            PG8_BAR; PG8_WAIT_L(0); PG8_MMA(1, 0, At, B0); PG8_BAR; PG8_SCHED;
            PG8_STAGE(PG8_SB(1, 1), b3 + hstepB, voffB);
            PG8_WAIT_V(6); PG8_BAR; PG8_MMA(1, 1, At, B1); PG8_BAR;
            }
        }
        if constexpr (ALIGN_EPI) { if (wr == 0) PG8_BAR; }
        if constexpr (!Epi::AFTER_DRAIN) { E(acc, cur, wr, wc, fr, fq); S.done(cur); }
        if (!has_next) break;
#pragma unroll
        for (int a = 0; a < 2; ++a)
#pragma unroll
            for (int b = 0; b < 2; ++b)
#pragma unroll
                for (int m = 0; m < 4; ++m)
#pragma unroll
                    for (int n = 0; n < 2; ++n) acc[a][b][m][n] = (f32x4){0.f, 0.f, 0.f, 0.f};
        cur = nxt; cA = nA; cB = nB; ++ui;
        if constexpr (ALIGN_EPI) { if (wr == 1) PG8_BAR; }
    }
    PG8_WAIT_V(0);
    if constexpr (!ALIGN_EPI) { if (wr == 0) PG8_BAR; }
    PG8_BAR;
    if constexpr (Epi::AFTER_DRAIN) { E.fused(acc, cur, wr, wc, fr, fq, lds, wid, lane); S.done(cur); }
#undef PG8_SA
#undef PG8_SB
#undef PG8_STAGE
#undef PG8_LDA
#undef PG8_LDB
#undef PG8_MMA
#undef PG8_WAIT_V
#undef PG8_WAIT_L
#undef PG8_BAR
#undef PG8_SCHED
}

}
using pg8::Unit;

__device__ __forceinline__ int brow_perm(int R) { return (R & ~31) + pg8::perm32(R & 31); }

template <int XOR> __device__ __forceinline__ void rope8(float (&x)[8], const float* ct, const float* st, bool plus) {
    const f32x4 c0 = *(const f32x4*)ct, c1 = *(const f32x4*)(ct + 4), s0 = *(const f32x4*)st, s1 = *(const f32x4*)(st + 4);
    const float c[8] = {c0[0], c0[1], c0[2], c0[3], c1[0], c1[1], c1[2], c1[3]}, s[8] = {s0[0], s0[1], s0[2], s0[3], s1[0], s1[1], s1[2], s1[3]};
#pragma unroll
    for (int f = 0; f < 8; ++f) { const float p = __shfl_xor(x[f], XOR); x[f] = x[f] * c[f] + (plus ? p : -p) * s[f]; }
}

struct EpiP {
    static constexpr bool AFTER_DRAIN = false;
    static __device__ __forceinline__ int brow(int R) { return brow_perm(R); }
    bf16_t* P; float* ssq_q; float* ssq_kv;
    __device__ __forceinline__ void operator()(const f32x4 (&acc)[2][2][4][2], const Unit& u, int wr, int wc, int fr, int fq) const {
        asm volatile("" : "+v"(fr), "+v"(fq));
        const int pn = u.pn; const bool lat = u.pm < 64;
#pragma unroll
        for (int ai = 0; ai < 2; ++ai)
#pragma unroll
            for (int m = 0; m < 4; ++m) {
                const int row = u.pm * 256 + ai * 128 + wr * 64 + m * 16 + fr;
                const int grow = (u.pm * 4 + ai * 2 + wr) & 31, gcol = m * 16 + fr;
                float ss = 0.f;
#pragma unroll
                for (int bj = 0; bj < 2; ++bj) {
                    float x[8];
#pragma unroll
                    for (int n = 0; n < 2; ++n)
#pragma unroll
                        for (int e = 0; e < 4; ++e) x[4 * n + e] = acc[ai][bj][m][n][e];
                    int mode = 0; float sc = 1.f;
                    if (pn == 1) mode = (bj == 1 && wc == 0) ? 1 : 0;
                    else if (pn == 2) { mode = 1; sc = DIFF_SC; }
                    else if (pn == 3) mode = 1;
                    else if (pn == 5) { mode = 2; sc = WIN_SC; }
                    else if (pn == 6) mode = (bj == 0) ? 2 : 0;
                    else if (pn == 7) sc = NA_SC;
                    if (!lat) mode = 0;
                    if (pn == 0 || (pn == 1 && bj == 0)) {
#pragma unroll
                        for (int f = 0; f < 8; ++f) ss += x[f] * x[f];
                    }
                    if (mode == 1) { const int pos = (fq < 2) ? grow : gcol; rope8<16>(x, ROPE_COS32 + pos * 8, ROPE_SIN32 + pos * 8, (fq & 1) != 0); }
                    else if (mode == 2) { const int pos = (wc & 1) ? gcol : grow; rope8<32>(x, ROPE_COS64 + pos * 16 + (fq & 1) * 8, ROPE_SIN64 + pos * 16 + (fq & 1) * 8, fq >= 2); }
                    u32x4 w; w.x = cvt_pk_bf16(x[0] * sc, x[1] * sc); w.y = cvt_pk_bf16(x[2] * sc, x[3] * sc); w.z = cvt_pk_bf16(x[4] * sc, x[5] * sc); w.w = cvt_pk_bf16(x[6] * sc, x[7] * sc);
                    *(u32x4*)(P + (size_t)row * PW + pn * 256 + bj * 128 + wc * 32 + fq * 8) = w;
                }
                if (pn <= 1) {
                    ss += __shfl_xor(ss, 16); ss += __shfl_xor(ss, 32);
                    if (fq == 0) unsafeAtomicAdd((pn == 0 ? ssq_q : ssq_kv) + row, ss);
                }
            }
    }
};

struct EpiUp {
    static constexpr bool AFTER_DRAIN = false;
    static __device__ __forceinline__ int brow(int R) { return brow_perm(R); }
    bf16_t* Q; const float* ssq_q; const float* ssq_kv;
    __device__ __forceinline__ void operator()(const f32x4 (&acc)[2][2][4][2], const Unit& u, int wr, int wc, int fr, int fq) const {
        asm volatile("" : "+v"(fr), "+v"(fq));
        const int pn = u.pn; const bool lat = u.pm < 64;
#pragma unroll
        for (int ai = 0; ai < 2; ++ai)
#pragma unroll
            for (int m = 0; m < 4; ++m) {
                const int row = u.pm * 256 + ai * 128 + wr * 64 + m * 16 + fr;
                const int grow = (u.pm * 4 + ai * 2 + wr) & 31, gcol = m * 16 + fr;
                const float rq = __builtin_amdgcn_rsqf(__hip_atomic_load(ssq_q + row, __ATOMIC_RELAXED, __HIP_MEMORY_SCOPE_AGENT) * (1.f / 256.f) + EPS) * MLA_SC;
                const float rkv = __builtin_amdgcn_rsqf(__hip_atomic_load(ssq_kv + row, __ATOMIC_RELAXED, __HIP_MEMORY_SCOPE_AGENT) * (1.f / 128.f) + EPS);
#pragma unroll
                for (int bj = 0; bj < 2; ++bj) {
                    const int g32 = pn * 8 + bj * 4 + wc;
                    float x[8];
#pragma unroll
                    for (int n = 0; n < 2; ++n)
#pragma unroll
                        for (int e = 0; e < 4; ++e) x[4 * n + e] = acc[ai][bj][m][n][e];
                    const float sc = g32 < 12 ? rq : (g32 < 28 ? rkv : 0.f);
                    if (g32 < 12 && (g32 % 3) == 2 && lat) { const int pos = (fq < 2) ? grow : gcol; rope8<16>(x, ROPE_COS32 + pos * 8, ROPE_SIN32 + pos * 8, (fq & 1) != 0); }
                    u32x4 w; w.x = cvt_pk_bf16(x[0] * sc, x[1] * sc); w.y = cvt_pk_bf16(x[2] * sc, x[3] * sc); w.z = cvt_pk_bf16(x[4] * sc, x[5] * sc); w.w = cvt_pk_bf16(x[6] * sc, x[7] * sc);
                    *(u32x4*)(Q + (size_t)row * QW + pn * 256 + bj * 128 + wc * 32 + fq * 8) = w;
                }
            }
    }
};

template <int ACT> struct EpiBf16 {
    static constexpr bool AFTER_DRAIN = false;
    static __device__ __forceinline__ int brow(int R) { return brow_perm(R); }
    bf16_t* O; int ldc;
    __device__ __forceinline__ void operator()(const f32x4 (&acc)[2][2][4][2], const Unit& u, int wr, int wc, int fr, int fq) const {
        asm volatile("" : "+v"(fr), "+v"(fq));
#pragma unroll
        for (int ai = 0; ai < 2; ++ai)
#pragma unroll
            for (int m = 0; m < 4; ++m) {
                bf16_t* rowp = O + (size_t)(u.pm * 256 + ai * 128 + wr * 64 + m * 16 + fr) * ldc + u.pn * 256 + wc * 32 + fq * 8;
#pragma unroll
                for (int bj = 0; bj < 2; ++bj) {
                    f32x4 v0 = acc[ai][bj][m][0], v1 = acc[ai][bj][m][1];
                    if (ACT == 1) {
#pragma unroll
                        for (int e = 0; e < 4; ++e) { const float a = fmaxf(v0[e], 0.f), b = fmaxf(v1[e], 0.f); v0[e] = a * a; v1[e] = b * b; }
                    }
                    u32x4 w; w.x = cvt_pk_bf16(v0[0], v0[1]); w.y = cvt_pk_bf16(v0[2], v0[3]); w.z = cvt_pk_bf16(v1[0], v1[1]); w.w = cvt_pk_bf16(v1[2], v1[3]);
                    *(u32x4*)(rowp + bj * 128) = w;
                }
            }
    }
};

struct EpiMerge {
    static constexpr bool AFTER_DRAIN = false;
    static __device__ __forceinline__ int brow(int R) { return ((R >> 4) & 1) * 1024 + 16 * (R >> 5) + (R & 15); }
    bf16_t* Y; const bf16_t* Bcat; const float* bg;
    __device__ __forceinline__ void operator()(const f32x4 (&acc)[2][2][4][2], const Unit& u, int wr, int wc, int fr, int fq) const {
        asm volatile("" : "+v"(fr), "+v"(fq));
        const int col = u.pn * 64 + wc * 16 + fq * 4;
        f32x4 bv[2][2];
#pragma unroll
        for (int bj = 0; bj < 2; ++bj)
#pragma unroll
            for (int n = 0; n < 2; ++n) bv[bj][n] = *(const f32x4*)(bg + (2 * bj + n) * 1024 + col);
#pragma unroll
        for (int ai = 0; ai < 2; ++ai)
#pragma unroll
            for (int m = 0; m < 4; ++m) {
                const int row = u.pm * 256 + ai * 128 + wr * 64 + m * 16 + fr;
                f32x4 y = {0.f, 0.f, 0.f, 0.f};
#pragma unroll
                for (int bj = 0; bj < 2; ++bj)
#pragma unroll
                    for (int n = 0; n < 2; ++n) {
                        const u32x2 bw = *(const u32x2*)(Bcat + (size_t)row * 4096 + (2 * bj + n) * 1024 + col);
                        const float b[4] = {bf_lo(bw.x), bf_hi(bw.x), bf_lo(bw.y), bf_hi(bw.y)};
#pragma unroll
                        for (int e = 0; e < 4; ++e) {
                            const float g = acc[ai][bj][m][n][e] + bv[bj][n][e];
                            const float sg = __builtin_amdgcn_rcpf(1.f + fast_exp2(-g * LOG2E));
                            y[e] += sg * b[e];
                        }
                    }
                u32x2 w; w.x = cvt_pk_bf16(y[0], y[1]); w.y = cvt_pk_bf16(y[2], y[3]);
                *(u32x2*)(Y + (size_t)row * DM + col) = w;
            }
    }
};

struct EpiRes {
    static constexpr bool AFTER_DRAIN = false;
    static __device__ __forceinline__ int brow(int R) { return R; }
    const float* old_lat; const float* old_ctx; float* new_lat; float* new_ctx; const float* modv;
    __device__ __forceinline__ void operator()(const f32x4 (&acc)[2][2][4][2], const Unit& u, int wr, int wc, int fr, int fq) const {
        asm volatile("" : "+v"(fr), "+v"(fq));
        const bool lat = u.pm < 64; const int r = lat ? (u.pm >> 3) : 8;
        const float* ob = lat ? old_lat : old_ctx - (size_t)NLAT * DM; float* nb = lat ? new_lat : new_ctx - (size_t)NLAT * DM;
        const int col0 = u.pn * 256 + wc * 32 + fq * 4;
        f32x4 gv[2][2];
#pragma unroll
        for (int bj = 0; bj < 2; ++bj)
#pragma unroll
            for (int n = 0; n < 2; ++n) gv[bj][n] = *(const f32x4*)(modv + (size_t)r * 6144 + col0 + bj * 128 + n * 16);
#pragma unroll
        for (int ai = 0; ai < 2; ++ai)
#pragma unroll
            for (int m = 0; m < 4; ++m) {
                const size_t off = (size_t)(u.pm * 256 + ai * 128 + wr * 64 + m * 16 + fr) * DM + col0;
#pragma unroll
                for (int bj = 0; bj < 2; ++bj)
#pragma unroll
                    for (int n = 0; n < 2; ++n) { const f32x4 o = *(const f32x4*)(ob + off + bj * 128 + n * 16); *(f32x4*)(nb + off + bj * 128 + n * 16) = o + gv[bj][n] * acc[ai][bj][m][n]; }
            }
    }
};

struct Args { const float* in[24]; float* out; unsigned char* ws; int ph_lo, ph_hi; };

struct Frame {
    LAS unsigned char* lds;
    int tid, lane, wave, G, vcu;
    Args a;
};

__device__ __forceinline__ void tr_item(const float* W, int ldw, int ks0, int cs0, bool valid, const float* gain, bf16_t* WT, int ldt, int n0, int k0, LAS float* scr, int lane) {
#pragma unroll 8
    for (int i = 0; i < 32; ++i) {
        const int kk = 2 * i + (lane >> 5), j = lane & 31; float v = 0.f;
        if (valid) { v = W[(size_t)(ks0 + kk) * ldw + cs0 + j]; if (gain) v *= gain[ks0 + kk]; }
        scr[kk * 33 + j] = v;
    }
    LDS_WAIT(); asm volatile("" ::: "memory");
    const int c = lane & 7;
#pragma unroll
    for (int j = 0; j < 4; ++j) { const int n = (lane >> 3) + 8 * j; const LAS float* s = scr + (8 * c) * 33 + n;
        u32x4 o; o.x = cvt_pk_bf16(s[0 * 33], s[1 * 33]); o.y = cvt_pk_bf16(s[2 * 33], s[3 * 33]); o.z = cvt_pk_bf16(s[4 * 33], s[5 * 33]); o.w = cvt_pk_bf16(s[6 * 33], s[7 * 33]);
        *(u32x4*)(WT + (size_t)(n0 + n) * ldt + k0 + 8 * c) = o; }
    LDS_WAIT(); asm volatile("" ::: "memory");
}
__device__ __forceinline__ void convert_weights(Frame& F, int l) {
    int lane_ = F.lane; asm volatile("" : "+v"(lane_));
    LAS float* scr = (LAS float*)(F.lds + F.wave * 16384);
    const int gw = F.vcu * NWAVES + F.wave, NGW = F.G * NWAVES;
    constexpr int I_IN = 16 * 80, I_UP = 6 * 32, I_G = 16 * 128, I_B = 16 * 32, I_O = 16 * 32, I_1 = 16 * 128, I_2 = 64 * 32;
    constexpr int NIT = I_IN + I_UP + I_G + I_B + I_O + I_1 + I_2;
    unsigned char* ws = F.a.ws;
    for (int it = gw; it < NIT; it += NGW) {
        int r = it;
        if (r < I_IN) { const int kb = r / 80, nb = r % 80, n0 = nb * 32; const bool valid = !(n0 >= 416 && n0 < 512); const int cs0 = n0 < 416 ? n0 : n0 - 96;
            tr_item(F.a.in[I_WIN] + (size_t)l * DM * INW, INW, kb * 64, cs0, valid, nullptr, (bf16_t*)(ws + WS_WIN), DM, n0, kb * 64, scr, lane_); continue; } r -= I_IN;
        if (r < I_UP) { const int kb = r / 32, nb = r % 32, n0 = nb * 32, k0 = kb * 64;
            if (kb < 4) tr_item(F.a.in[I_WUQ] + (size_t)l * 256 * 384, 384, k0, n0, n0 < 384, F.a.in[I_QNORM] + l * 256, (bf16_t*)(ws + WS_WUP), 384, n0, k0, scr, lane_);
            else tr_item(F.a.in[I_WUKV] + (size_t)l * 128 * 512, 512, k0 - 256, n0 - 384, n0 >= 384 && n0 < 896, F.a.in[I_KVNORM] + l * 128, (bf16_t*)(ws + WS_WUP), 384, n0, k0, scr, lane_);
            continue; } r -= I_UP;
        if (r < I_G) { const int kb = r / 128, nb = r % 128; tr_item(F.a.in[I_WGATE] + (size_t)l * DM * 4096, 4096, kb * 64, nb * 32, true, nullptr, (bf16_t*)(ws + WS_WGATE), DM, nb * 32, kb * 64, scr, lane_); continue; } r -= I_G;
        if (r < I_B) { const int kb = r / 32, nb = r % 32; tr_item(F.a.in[I_WBR] + (size_t)l * DM * DM, DM, kb * 64, nb * 32, true, nullptr, (bf16_t*)(ws + WS_WBR), DM, nb * 32, kb * 64, scr, lane_); continue; } r -= I_B;
        if (r < I_O) { const int kb = r / 32, nb = r % 32; tr_item(F.a.in[I_WOUT] + (size_t)l * DM * DM, DM, kb * 64, nb * 32, true, nullptr, (bf16_t*)(ws + WS_WOUT), DM, nb * 32, kb * 64, scr, lane_); continue; } r -= I_O;
        if (r < I_1) { const int kb = r / 128, nb = r % 128; tr_item(F.a.in[I_FF1] + (size_t)l * DM * FF, FF, kb * 64, nb * 32, true, nullptr, (bf16_t*)(ws + WS_WFF1), DM, nb * 32, kb * 64, scr, lane_); continue; } r -= I_1;
        { const int kb = r / 32, nb = r % 32; tr_item(F.a.in[I_FF2] + (size_t)l * FF * DM, DM, kb * 64, nb * 32, true, nullptr, (bf16_t*)(ws + WS_WFF2), FF, nb * 32, kb * 64, scr, lane_); }
    }
}

__device__ __forceinline__ void mod_vectors(Frame& F) {
    const int t = blockIdx.x; if (t >= 192) return;
    int lane_ = F.lane, tid_ = F.tid; asm volatile("" : "+v"(lane_), "+v"(tid_));
    const int l = t / 96, col = (t % 96) * 64 + lane_;
    LAS float* sv = (LAS float*)F.lds;
    LAS float* red = (LAS float*)(F.lds + 9 * 1024 * 4);
    for (int i = tid_; i < 9 * 1024; i += 512) { const int r = i >> 10, k = i & 1023; const float x = r < 8 ? F.a.in[I_C][r * 1024 + k] : F.a.in[I_CCTX][k]; sv[i] = x / (1.f + __expf(-x)); }
    __syncthreads();
    float a[9];
#pragma unroll
    for (int r = 0; r < 9; ++r) a[r] = 0.f;
    const float* w = F.a.in[I_WADA] + (size_t)l * DM * 6144 + col;
    const int kbeg = F.wave * 128;
#pragma unroll 4
    for (int k = kbeg; k < kbeg + 128; ++k) { const float wv = w[(size_t)k * 6144];
#pragma unroll
        for (int r = 0; r < 9; ++r) a[r] += sv[r * 1024 + k] * wv; }
#pragma unroll
    for (int r = 0; r < 9; ++r) red[(F.wave * 9 + r) * 64 + lane_] = a[r];
    __syncthreads();
    if (F.wave == 0) {
        const float bb = F.a.in[I_BADA][l * 6144 + col];
        float* mod = (float*)(F.a.ws + WS_MOD) + (size_t)l * 9 * 6144;
#pragma unroll
        for (int r = 0; r < 9; ++r) { float s = bb;
#pragma unroll
            for (int wv = 0; wv < 8; ++wv) s += red[(wv * 9 + r) * 64 + lane_];
            mod[r * 6144 + col] = s; }
    }
    __syncthreads();
}

__device__ __forceinline__ void adaln_rows(Frame& F, const float* xlat, const float* xctx, int nrows, const float* g, const float* modl, int c_shift, int c_scale, bf16_t* H) {
    const int gw = F.vcu * NWAVES + F.wave, NGW = F.G * NWAVES;
    int lane_ = F.lane; asm volatile("" : "+v"(lane_));
    for (int row = gw; row < nrows; row += NGW) {
        const float* xr = row < NLAT ? xlat + (size_t)row * DM : xctx + (size_t)(row - NLAT) * DM;
        const int r = row < NLAT ? (row >> 11) : 8;
        const float* sh = modl + (size_t)r * 6144 + c_shift * 1024; const float* sc = modl + (size_t)r * 6144 + c_scale * 1024;
        f32x4 v[4]; float s = 0.f;
#pragma unroll
        for (int j = 0; j < 4; ++j) { v[j] = *(const f32x4*)(xr + 256 * j + 4 * lane_); s += (v[j][0] * v[j][0] + v[j][1] * v[j][1]) + (v[j][2] * v[j][2] + v[j][3] * v[j][3]); }
        const float rstd = 1.f / sqrtf(wave_sum(s) * (1.f / DM) + EPS);
#pragma unroll
        for (int j = 0; j < 4; ++j) {
            const int c = 256 * j + 4 * lane_;
            const f32x4 gg = *(const f32x4*)(g + c), s1 = *(const f32x4*)(sc + c), s0 = *(const f32x4*)(sh + c);
            f32x4 o;
#pragma unroll
            for (int e = 0; e < 4; ++e) o[e] = (v[j][e] * rstd * gg[e]) * (1.f + s1[e]) + s0[e];
            u32x2 w; w.x = cvt_pk_bf16(o[0], o[1]); w.y = cvt_pk_bf16(o[2], o[3]);
            *(u32x2*)(H + (size_t)row * DM + c) = w;
        }
    }
}
__device__ __forceinline__ void final_norm(Frame& F) {
    const int gw = F.vcu * NWAVES + F.wave, NGW = F.G * NWAVES;
    const float* g = F.a.in[I_FNORM];
    int lane_ = F.lane; asm volatile("" : "+v"(lane_));
    for (int row = gw; row < NLAT; row += NGW) {
        float* xr = F.a.out + (size_t)row * DM;
        f32x4 v[4]; float s = 0.f;
#pragma unroll
        for (int j = 0; j < 4; ++j) { v[j] = *(const f32x4*)(xr + 256 * j + 4 * lane_); s += (v[j][0] * v[j][0] + v[j][1] * v[j][1]) + (v[j][2] * v[j][2] + v[j][3] * v[j][3]); }
        const float rstd = 1.f / sqrtf(wave_sum(s) * (1.f / DM) + EPS);
#pragma unroll
        for (int j = 0; j < 4; ++j) { const int c = 256 * j + 4 * lane_; const f32x4 gg = *(const f32x4*)(g + c); *(f32x4*)(xr + c) = v[j] * rstd * gg; }
    }
}

template <int N> __device__ __forceinline__ void ld_bf(const bf16_t* p, float* out) {
#pragma unroll
    for (int i = 0; i < N / 8; ++i) { const u32x4 w = *(const u32x4*)(p + 8 * i);
        out[8 * i + 0] = bf_lo(w.x); out[8 * i + 1] = bf_hi(w.x); out[8 * i + 2] = bf_lo(w.y); out[8 * i + 3] = bf_hi(w.y);
        out[8 * i + 4] = bf_lo(w.z); out[8 * i + 5] = bf_hi(w.z); out[8 * i + 6] = bf_lo(w.w); out[8 * i + 7] = bf_hi(w.w); }
}
template <int N> __device__ __forceinline__ float dot_bf(const float* q, const bf16_t* k) {
    float s = 0.f;
#pragma unroll
    for (int i = 0; i < N / 8; ++i) { const u32x4 w = *(const u32x4*)(k + 8 * i);
        s += q[8 * i + 0] * bf_lo(w.x) + q[8 * i + 1] * bf_hi(w.x) + q[8 * i + 2] * bf_lo(w.y) + q[8 * i + 3] * bf_hi(w.y)
           + q[8 * i + 4] * bf_lo(w.z) + q[8 * i + 5] * bf_hi(w.z) + q[8 * i + 6] * bf_lo(w.w) + q[8 * i + 7] * bf_hi(w.w); }
    return s;
}
struct Soft32 {
    float m, l, o[32];
    __device__ __forceinline__ void init() { m = -1e30f; l = 0.f;
#pragma unroll
        for (int d = 0; d < 32; ++d) o[d] = 0.f; }
    __device__ __forceinline__ void add(float s, const bf16_t* v) {
        const float mn = fmaxf(m, s), a = fast_exp2(m - mn), p = fast_exp2(s - mn); m = mn; l = l * a + p;
#pragma unroll
        for (int i = 0; i < 4; ++i) { const u32x4 w = *(const u32x4*)(v + 8 * i);
            o[8 * i + 0] = o[8 * i + 0] * a + p * bf_lo(w.x); o[8 * i + 1] = o[8 * i + 1] * a + p * bf_hi(w.x);
            o[8 * i + 2] = o[8 * i + 2] * a + p * bf_lo(w.y); o[8 * i + 3] = o[8 * i + 3] * a + p * bf_hi(w.y);
            o[8 * i + 4] = o[8 * i + 4] * a + p * bf_lo(w.z); o[8 * i + 5] = o[8 * i + 5] * a + p * bf_hi(w.z);
            o[8 * i + 6] = o[8 * i + 6] * a + p * bf_lo(w.w); o[8 * i + 7] = o[8 * i + 7] * a + p * bf_hi(w.w); }
    }
    __device__ __forceinline__ void add_sink(float s) { const float mn = fmaxf(m, s), a = fast_exp2(m - mn), p = fast_exp2(s - mn); m = mn; l = l * a + p;
#pragma unroll
        for (int d = 0; d < 32; ++d) o[d] *= a; }
    __device__ __forceinline__ void store(bf16_t* dst) const { const float il = 1.f / l;
#pragma unroll
        for (int i = 0; i < 4; ++i) { u32x4 w; w.x = cvt_pk_bf16(o[8 * i] * il, o[8 * i + 1] * il); w.y = cvt_pk_bf16(o[8 * i + 2] * il, o[8 * i + 3] * il);
            w.z = cvt_pk_bf16(o[8 * i + 4] * il, o[8 * i + 5] * il); w.w = cvt_pk_bf16(o[8 * i + 6] * il, o[8 * i + 7] * il); *(u32x4*)(dst + 8 * i) = w; } }
};

struct AttnBufs { const bf16_t* P; const bf16_t* Q; bf16_t* O; const float* dlam; const float* subln; const float* sink; const float* rpb; float lam_init; bool need_ctx; };

__device__ __forceinline__ void attn_simple(Frame& F, const AttnBufs& T) {
    const int nq_lat = NBATCH * 4 * 8;
    const int nq_ctx = T.need_ctx ? NBATCH * 4 : 0;
    const int per_branch = nq_lat + nq_ctx, total = 4 * per_branch;
    int tid_ = F.tid; asm volatile("" : "+v"(tid_));
    const int dh = (tid_ & 1) * 32;
    for (int it = blockIdx.x; it < total; it += F.G) {
        const int br = it / per_branch; int r = it % per_branch;
        const bool cq = r >= nq_lat; int b, h, q;
        if (!cq) { b = r / 32; h = (r >> 3) & 3; q = (r & 7) * 256 + (tid_ >> 1); } else { r -= nq_lat; b = r >> 2; h = r & 3; q = tid_ >> 1; }
        const int row = cq ? NLAT + b * CTXL + q : b * SEQ + q;
        const int ctx0 = NLAT + b * CTXL, lat0 = b * SEQ;
        const int nkl = cq ? 0 : SEQ;
        if (br == 0) {
            float qv[96]; ld_bf<96>(T.Q + (size_t)row * QW + 96 * h, qv);
            Soft32 S; S.init();
            for (int j = 0; j < CTXL + nkl; ++j) { const int kr = j < CTXL ? ctx0 + j : lat0 + j - CTXL;
                const bf16_t* kn = T.Q + (size_t)kr * QW + UC_KV + 128 * h;
                const float s = dot_bf<64>(qv, kn) + dot_bf<32>(qv + 64, T.P + (size_t)kr * PW + PC_KR);
                S.add(s, kn + 64 + dh); }
            S.store(T.O + (size_t)row * DM + 0 + 64 * h + dh);
        } else if (br == 1) {
            float q1[32], q2[32]; ld_bf<32>(T.P + (size_t)row * PW + PC_DQ + 64 * h, q1); ld_bf<32>(T.P + (size_t)row * PW + PC_DQ + 64 * h + 32, q2);
            Soft32 S1, S2; S1.init(); S2.init();
            for (int j = 0; j < CTXL + nkl; ++j) { const int kr = j < CTXL ? ctx0 + j : lat0 + j - CTXL;
                const bf16_t* kp = T.P + (size_t)kr * PW + PC_DK + 64 * h; const bf16_t* vp = T.P + (size_t)kr * PW + PC_DV + 64 * h + dh;
                S1.add(dot_bf<32>(q1, kp), vp); S2.add(dot_bf<32>(q2, kp + 32), vp); }
            float a0 = 0.f, a1 = 0.f;
#pragma unroll
            for (int i = 0; i < 32; ++i) { a0 += T.dlam[i] * T.dlam[32 + i]; a1 += T.dlam[64 + i] * T.dlam[96 + i]; }
            const float lam = __expf(a0) - __expf(a1) + T.lam_init;
            const float i1 = 1.f / S1.l, i2 = lam / S2.l; float ss = 0.f;
#pragma unroll
            for (int d = 0; d < 32; ++d) { S1.o[d] = S1.o[d] * i1 - S2.o[d] * i2; ss += S1.o[d] * S1.o[d]; }
            ss += __shfl_xor(ss, 1);
            const float rs = (1.f / sqrtf(ss * (1.f / 64.f) + EPS)) * (1.f - T.lam_init);
#pragma unroll
            for (int d = 0; d < 32; ++d) S1.o[d] *= rs * T.subln[dh + d];
            S1.l = 1.f; S1.store(T.O + (size_t)row * DM + 256 + 64 * h + dh);
        } else if (br == 2) {
            const int kvh = h >> 1;
            float qv[64]; ld_bf<64>(T.P + (size_t)row * PW + PC_WQ + 64 * h, qv);
            Soft32 S; S.init();
            for (int j = 0; j < CTXL; ++j) { const int kr = ctx0 + j; S.add(dot_bf<64>(qv, T.P + (size_t)kr * PW + PC_WK + 64 * kvh), T.P + (size_t)kr * PW + PC_WV + 64 * kvh + dh); }
            if (!cq) { const int k0 = q - 128 < 0 ? 0 : q - 128, k1 = q + 128 > SEQ - 1 ? SEQ - 1 : q + 128;
                for (int kp = k0; kp <= k1; ++kp) { const int kr = lat0 + kp; S.add(dot_bf<64>(qv, T.P + (size_t)kr * PW + PC_WK + 64 * kvh), T.P + (size_t)kr * PW + PC_WV + 64 * kvh + dh); } }
            S.add_sink(T.sink[h] * LOG2E);
            S.store(T.O + (size_t)row * DM + 512 + 64 * h + dh);
        } else {
            float qv[64]; ld_bf<64>(T.P + (size_t)row * PW + PC_NQ + 64 * h, qv);
            Soft32 S; S.init();
            for (int j = 0; j < CTXL; ++j) { const int kr = ctx0 + j; S.add(dot_bf<64>(qv, T.P + (size_t)kr * PW + PC_NK + 64 * h), T.P + (size_t)kr * PW + PC_NV + 64 * h + dh); }
            if (!cq) { const int gr = q >> 6, gc = q & 63;
                int rs = gr - 4; rs = rs < 0 ? 0 : (rs > 24 ? 24 : rs);
                int cs = gc - 8; cs = cs < 0 ? 0 : (cs > 48 ? 48 : cs);
                for (int kr_ = rs; kr_ < rs + 8; ++kr_) for (int kc = cs; kc < cs + 16; ++kc) { const int kr = lat0 + kr_ * 64 + kc;
                    const float bias = T.rpb[(h * 15 + (kr_ - gr + 7)) * 31 + (kc - gc + 15)] * LOG2E;
                    S.add(dot_bf<64>(qv, T.P + (size_t)kr * PW + PC_NK + 64 * h) + bias, T.P + (size_t)kr * PW + PC_NV + 64 * h + dh); } }
            S.store(T.O + (size_t)row * DM + 768 + 64 * h + dh);
        }
    }
}

__global__ void __launch_bounds__(NWAVES * 64, 2) mega(Args args) {
    extern __shared__ __attribute__((aligned(16))) unsigned char lds[];
    Frame F;
    F.lds = (LAS unsigned char*)lds; F.tid = threadIdx.x; F.lane = F.tid & 63; F.wave = __builtin_amdgcn_readfirstlane(F.tid >> 6);
    F.G = gridDim.x; { const int bx = blockIdx.x; F.vcu = (F.G % 8 == 0) ? (bx % 8) * (F.G / 8) + bx / 8 : bx; }
    F.a = args;
    volatile LAS unsigned* MISC = (volatile LAS unsigned*)(F.lds + MISC_OFF);
    for (int u = F.tid; u < (LDS_BYTES - RING_BYTES) / 4; u += NWAVES * 64) ((LAS unsigned*)(F.lds + RING_BYTES))[u] = 0u;
    __syncthreads();
    unsigned* ctl = (unsigned*)args.ws;
    XcdBarrier bar = xcd_barrier_post(ctl + CW_BAR, MISC + 8);
    unsigned char* ws = args.ws;
    const int lo = args.ph_lo, hi = args.ph_hi;
    bool first_bar = true;
#define IN(k) (lo <= (k) && (k) < hi)
#define SEAM(k) do { if (IN(k) && IN((k) + 1)) { if (first_bar) { cg::this_grid().sync(); first_bar = false; } else xcd_barrier(bar); } } while (0)
    float* modall = (float*)(ws + WS_MOD);
    float* ssq = (float*)(ws + WS_SSQ);
    bf16_t* Wt_in = (bf16_t*)(ws + WS_WIN); bf16_t* Wt_up = (bf16_t*)(ws + WS_WUP); bf16_t* Wt_g = (bf16_t*)(ws + WS_WGATE); bf16_t* Wt_b = (bf16_t*)(ws + WS_WBR);
    bf16_t* Wt_o = (bf16_t*)(ws + WS_WOUT); bf16_t* Wt_1 = (bf16_t*)(ws + WS_WFF1); bf16_t* Wt_2 = (bf16_t*)(ws + WS_WFF2);
    float* XC = (float*)(ws + WS_XC);
    int ph = 0;
    if (IN(ph)) { mod_vectors(F); convert_weights(F, 0); }
    SEAM(ph); ++ph;
    for (int l = 0; l < 2; ++l) {
        const bool need_ctx = (l == 0);
        const int nMall = NTOK / 256, nMlat = need_ctx ? NTOK / 256 : NLAT / 256;
        bf16_t* H   = l == 0 ? (bf16_t*)F.a.out : (bf16_t*)(ws + WS_H1);
        bf16_t* OY  = l == 0 ? (bf16_t*)(ws + WS_H1) : (bf16_t*)(ws + WS_BIG);
        bf16_t* Pb  = l == 0 ? (bf16_t*)(ws + WS_BIG) : (bf16_t*)(ws + WS_BIG + 32 * MiB);
        bf16_t* Qb  = l == 0 ? (bf16_t*)(ws + WS_BIG + 90 * MiB) : (bf16_t*)(ws + WS_BIG + 122 * MiB);
        bf16_t* Bc  = Pb;
        bf16_t* H2  = (bf16_t*)(ws + WS_H1);
        bf16_t* U   = Pb;
        const float* modl = modall + (size_t)l * 9 * 6144;
        float* ssq_q = ssq + (size_t)(2 * l) * NTOK; float* ssq_kv = ssq + (size_t)(2 * l + 1) * NTOK;
        const float* xlat = l == 0 ? F.a.in[I_X] : F.a.out; const float* xctx = l == 0 ? F.a.in[I_CTX] : XC;
        if (IN(ph)) { if (l == 1) convert_weights(F, 1); adaln_rows(F, xlat, xctx, NTOK, F.a.in[I_NMIX] + l * DM, modl, 0, 1, H); }
        SEAM(ph); ++ph;
        if (IN(ph)) { pg8::Prob g = pg8::plain_prob(H, DM, Wt_in, DM); pg8::StaticOrder S; S.init(nMall, PW / 256, F.G, (int)blockIdx.x);
            EpiP E{Pb, ssq_q, ssq_kv}; pg8::gemm_phase<EpiP, pg8::Prob, pg8::StaticOrder, true, true>(F.lds, g, S, E); }
        SEAM(ph); ++ph;
        if (IN(ph)) { pg8::Prob g = pg8::plain_prob(Pb, PW, Wt_up, 384); g.nt = 6; pg8::StaticOrder S; S.init(nMall, 4, F.G, (int)blockIdx.x);
            EpiUp E{Qb, ssq_q, ssq_kv}; pg8::gemm_phase<EpiUp, pg8::Prob, pg8::StaticOrder, true, true>(F.lds, g, S, E); }
        SEAM(ph); ++ph;
        if (IN(ph)) { AttnBufs T{Pb, Qb, OY, F.a.in[I_DLAM] + l * 128, F.a.in[I_SUBLN] + l * 64, F.a.in[I_SINK] + l * 4, F.a.in[I_RPB] + l * 4 * 15 * 31, l == 0 ? 0.2f : 0.35550907f, need_ctx};
            attn_simple(F, T); }
        SEAM(ph); ++ph;
        if (IN(ph)) { pg8::Prob g; g.A = (const char*)OY; g.B = (const char*)Wt_b; g.nt = 4; g.lda = DM; g.ldb = DM; g.hstepB = (size_t)128 * DM * 2;
            g.a_pm = (size_t)256 * DM * 2; g.a_pnhi = 512; g.a_sh = 2; g.b_pnlo = (size_t)256 * DM * 2; g.b_pnhi = 512; g.b_mask = 3; g.b_sh = 2;
            pg8::StaticOrder S; S.init(nMlat, 16, F.G, (int)blockIdx.x);
            EpiBf16<0> E{Bc, 4096}; pg8::gemm_phase<EpiBf16<0>, pg8::Prob, pg8::StaticOrder, true, true>(F.lds, g, S, E); }
        SEAM(ph); ++ph;
        if (IN(ph)) { pg8::Prob g; g.A = (const char*)H; g.B = (const char*)Wt_g; g.nt = 16; g.lda = DM; g.ldb = DM; g.hstepB = (size_t)2048 * DM * 2;
            g.a_pm = (size_t)256 * DM * 2; g.a_pnhi = 0; g.a_sh = 0; g.b_pnlo = (size_t)64 * DM * 2; g.b_pnhi = 0; g.b_mask = ~0; g.b_sh = 0;
            pg8::StaticOrder S; S.init(nMlat, 16, F.G, (int)blockIdx.x);
            EpiMerge E{OY, Bc, F.a.in[I_BGATE] + l * 4096}; pg8::gemm_phase<EpiMerge, pg8::Prob, pg8::StaticOrder, true, true>(F.lds, g, S, E); }
        SEAM(ph); ++ph;
        if (IN(ph)) { pg8::Prob g = pg8::plain_prob(OY, DM, Wt_o, DM); pg8::StaticOrder S; S.init(nMlat, 4, F.G, (int)blockIdx.x);
            EpiRes E{xlat, xctx, F.a.out, XC, modl + 2 * 1024}; pg8::gemm_phase<EpiRes, pg8::Prob, pg8::StaticOrder, true, true>(F.lds, g, S, E); }
        SEAM(ph); ++ph;
        if (IN(ph)) adaln_rows(F, F.a.out, XC, nMlat * 256, F.a.in[I_NFFN] + l * DM, modl, 3, 4, H2);
        SEAM(ph); ++ph;
        if (IN(ph)) { pg8::Prob g = pg8::plain_prob(H2, DM, Wt_1, DM); pg8::StaticOrder S; S.init(nMlat, 16, F.G, (int)blockIdx.x);
            EpiBf16<1> E{U, FF}; pg8::gemm_phase<EpiBf16<1>, pg8::Prob, pg8::StaticOrder, true, true>(F.lds, g, S, E); }
        SEAM(ph); ++ph;
        if (IN(ph)) { pg8::Prob g = pg8::plain_prob(U, FF, Wt_2, FF); pg8::StaticOrder S; S.init(nMlat, 4, F.G, (int)blockIdx.x);
            EpiRes E{F.a.out, XC, F.a.out, XC, modl + 5 * 1024}; pg8::gemm_phase<EpiRes, pg8::Prob, pg8::StaticOrder, true, true>(F.lds, g, S, E); }
        SEAM(ph); ++ph;
    }
    if (IN(ph)) final_norm(F);
#undef IN
#undef SEAM
}

constexpr int N_PHASES = 1 + 2 * 10 + 1;

extern "C" void kernel_launch(void* const* d_in, const int* in_sizes, int n_in, void* d_out, int out_size, void* d_ws, size_t ws_size, hipStream_t stream) {
    static int grid = 0;
    if (grid == 0) {
        int dev = 0, cus = 0, per_cu = 0;
        if (n_in != 24 || out_size != NLAT * DM || ws_size < 256 * MiB) { fprintf(stderr, "kernel_launch: unexpected shapes (n_in %d out %d ws %zu)\n", n_in, out_size, ws_size); grid = -1; return; }
        if (hipGetDevice(&dev) != hipSuccess || hipDeviceGetAttribute(&cus, hipDeviceAttributeMultiprocessorCount, dev) != hipSuccess) { grid = -1; return; }
        if (hipFuncSetAttribute((const void*)mega, hipFuncAttributeMaxDynamicSharedMemorySize, LDS_BYTES) != hipSuccess) { fprintf(stderr, "hipFuncSetAttribute failed\n"); grid = -1; return; }
        if (hipOccupancyMaxActiveBlocksPerMultiprocessor(&per_cu, (const void*)mega, NWAVES * 64, LDS_BYTES) != hipSuccess || per_cu < 1) { fprintf(stderr, "occupancy query: %d\n", per_cu); grid = -1; return; }
        (void)hipGetLastError();
        grid = cus;
    }
    if (grid < 0) return;
    (void)hipMemsetAsync(d_ws, 0, CTL_ZERO_BYTES, stream);
    Args a{};
    for (int i = 0; i < 24; ++i) a.in[i] = (const float*)d_in[i];
    a.out = (float*)d_out; a.ws = (unsigned char*)d_ws; a.ph_lo = 0; a.ph_hi = N_PHASES;
    void* kargs[] = {&a};
    hipError_t e = hipLaunchCooperativeKernel((const void*)mega, dim3(grid), dim3(NWAVES * 64), kargs, LDS_BYTES, stream);
    if (e != hipSuccess) fprintf(stderr, "cooperative launch failed: %s (grid %d)\n", hipGetErrorString(e), grid);
}
```

```cpp
#include <hip/hip_runtime.h>
#include <hip/hip_cooperative_groups.h>
#include <cstdio>
#include <cstdint>
namespace cg = cooperative_groups;

#define LAS __attribute__((address_space(3)))
#define GAS __attribute__((address_space(1)))
#define PG8_LAS __attribute__((address_space(3)))

typedef unsigned short bf16_t;
typedef short bf16x8 __attribute__((ext_vector_type(8)));
typedef float f32x4 __attribute__((ext_vector_type(4)));
typedef float f32x2 __attribute__((ext_vector_type(2)));
typedef unsigned u32x4 __attribute__((ext_vector_type(4)));
typedef unsigned u32x2 __attribute__((ext_vector_type(2)));

constexpr int DM = 1024, NBATCH = 8, SEQ = 2048, CTXL = 256, NLAT = NBATCH * SEQ, NCTX = NBATCH * CTXL, NTOK = NLAT + NCTX, FF = 4096;
constexpr int PW = 2560;
constexpr int QW = 1024;
constexpr int INW = 2464;
constexpr int PC_CQ = 0, PC_CKV = 256, PC_KR = 384, PC_DQ = 512, PC_DK = 768, PC_DV = 1024, PC_WQ = 1280, PC_WK = 1536, PC_WV = 1664, PC_NQ = 1792, PC_NK = 2048, PC_NV = 2304;
constexpr int UC_KV = 384;
constexpr float LOG2E = 1.4426950408889634f;
constexpr float MLA_SC = 0.10206207261596577f * LOG2E;
constexpr float DIFF_SC = 0.17677669529663687f * LOG2E;
constexpr float WIN_SC = 0.125f * LOG2E, NA_SC = 0.125f * LOG2E;
constexpr float EPS = 1e-6f;

enum { I_X = 0, I_C, I_CTX, I_CCTX, I_WADA, I_BADA, I_NMIX, I_NFFN, I_WIN, I_QNORM, I_KVNORM, I_WUQ, I_WUKV, I_DLAM, I_SUBLN, I_SINK, I_RPB, I_WGATE, I_BGATE, I_WBR, I_WOUT, I_FF1, I_FF2, I_FNORM };

constexpr size_t MiB = 1u << 20;
constexpr size_t CTL_ZERO_BYTES = 1 * MiB;
constexpr int CW_BAR = 4096;
constexpr size_t WS_SSQ = 64 * 1024;
constexpr size_t WS_MOD = 1 * MiB;
constexpr size_t WS_WIN = 4 * MiB, WS_WUP = 9 * MiB, WS_WGATE = 10 * MiB, WS_WBR = 18 * MiB, WS_WOUT = 20 * MiB, WS_WFF1 = 22 * MiB, WS_WFF2 = 30 * MiB;
constexpr size_t WS_XC = 38 * MiB, WS_H1 = 46 * MiB, WS_BIG = 82 * MiB;
static_assert(WS_SSQ + (size_t)4 * NTOK * 4 <= CTL_ZERO_BYTES, "ssq inside memset region");

constexpr int NWAVES = 8;
constexpr int RING_BYTES = 131072;
constexpr int MISC_OFF = RING_BYTES + 320;
constexpr int LDS_BYTES = 147456;

__device__ const float ROPE_COS32[512] = {1.0f,1.0f,1.0f,1.0f,1.0f,1.0f,1.0f,1.0f,0.540302277f,0.950415254f,0.995004177f,0.999500036f,0.999949992f,0.999994993f,0.999999523f,0.99999994f,-0.416146845f,0.806578398f,0.980066597f,0.998000681f,0.999800026f,0.999979973f,0.999997973f,0.999999821f,-0.989992499f,0.582753599f,0.955336511f,0.995503366f,0.999550045f,0.999954998f,0.99999553f,0.999999523f,-0.653643608f,0.301137477f,0.921060979f,0.992010653f,0.999200106f,0.999920011f,0.999992013f,0.999999225f,0.2836622f,-0.0103423186f,0.87758255f,0.987526f,0.998750269f,0.999875009f,0.999987483f,0.999998748f,0.960170269f,-0.32079646f,0.825335622f,0.982053936f,0.998200536f,0.999819994f,0.999981999f,0.999998212f,0.753902256f,-0.599437416f,0.764842212f,0.975599885f,0.997551024f,0.999755025f,0.999975502f,0.999997556f,-0.145500034f,-0.818632483f,0.696706712f,0.968170285f,0.996801734f,0.999680042f,0.999967992f,0.999996781f,-0.91113025f,-0.956644177f,0.621609986f,0.959772646f,0.995952725f,0.999595046f,0.999959528f,0.999995947f,-0.839071512f,-0.999786079f,0.540302277f,0.950415254f,0.995004177f,0.999500036f,0.999949992f,0.999994993f,0.00442569796f,-0.943779707f,0.453596115f,0.940107584f,0.993956089f,0.999395072f,0.999939501f,0.99999392f,0.843853951f,-0.794179261f,0.362357765f,0.92885989f,0.99280864f,0.999280095f,0.999927998f,0.999992788f,0.907446802f,-0.565820515f,0.267498821f,0.916683376f,0.99156189f,0.999155104f,0.999915481f,0.999991536f,0.136737213f,-0.281349629f,0.169967145f,0.903590262f,0.990216017f,0.999020159f,0.99990201f,0.999990225f,-0.759687901f,0.0310225319f,0.070737198f,0.889593601f,0.988771081f,0.998875201f,0.999887526f,0.999988735f,-0.957659483f,0.340318203f,-0.029199522f,0.87470746f,0.987227261f,0.998720288f,0.999872029f,0.999987185f,-0.275163352f,0.615864694f,-0.1288445f,0.858946681f,0.985584795f,0.998555362f,0.999855518f,0.999985576f,0.660316706f,0.830336273f,-0.227202088f,0.842327058f,0.983843684f,0.998380423f,0.999837995f,0.999983788f,0.988704622f,0.962463796f,-0.323289573f,0.824865103f,0.982004225f,0.998195529f,0.999819517f,0.99998194f,0.408082068f,0.999144375f,-0.416146845f,0.806578398f,0.980066597f,0.998000681f,0.999800026f,0.999979973f,-0.547729254f,0.936740339f,-0.504846096f,0.787485182f,0.97803092f,0.99779582f,0.999779522f,0.999977946f,-0.99996084f,0.781440318f,-0.588501096f,0.76760453f,0.975897431f,0.997581005f,0.999758005f,0.999975801f,-0.53283304f,0.548645318f,-0.666276038f,0.746956348f,0.97366637f,0.997356176f,0.999735534f,0.999973536f,0.424179018f,0.26144141f,-0.737393737f,0.725561321f,0.971337974f,0.997121394f,0.99971199f,0.999971211f,0.991202831f,-0.051689472f,-0.801143587f,0.703440726f,0.968912423f,0.996876657f,0.999687493f,0.999968767f,0.64691931f,-0.359694332f,-0.856888771f,0.680616736f,0.966389954f,0.996621907f,0.999662042f,0.999966204f,-0.292138815f,-0.63202852f,-0.904072165f,0.657112241f,0.963770926f,0.996357203f,0.999635518f,0.999963522f,-0.962605894f,-0.841684759f,-0.942222357f,0.632950664f,0.961055458f,0.996082544f,0.99960804f,0.99996078f,-0.748057544f,-0.967871606f,-0.970958173f,0.608156204f,0.958243847f,0.995797932f,0.999579549f,0.999957979f,0.154251456f,-0.998075187f,-0.989992499f,0.582753599f,0.955336511f,0.995503366f,0.999550045f,0.999954998f,0.914742351f,-0.929300189f,-0.999135137f,0.556768298f,0.95233357f,0.995198846f,0.999519527f,0.999951959f,0.83422339f,-0.768367052f,-0.998294771f,0.53022635f,0.949235439f,0.994884372f,0.999488056f,0.9999488f,-0.0132767474f,-0.531235337f,-0.987479746f,0.503154159f,0.946042359f,0.994559944f,0.999455571f,0.999945521f,-0.848570287f,-0.241421327f,-0.966798186f,0.475578845f,0.942754686f,0.994225562f,0.999422073f,0.999942183f,-0.903692186f,0.072334297f,-0.93645668f,0.447528005f,0.939372718f,0.993881226f,0.999387562f,0.999938726f,-0.127963692f,0.378916562f,-0.896758437f,0.419029653f,0.935896814f,0.993526995f,0.999352098f,0.99993521f,0.765414059f,0.64792192f,-0.848100007f,0.39011234f,0.93232733f,0.993162811f,0.99931556f,0.999931574f,0.955073655f,0.852673173f,-0.790967703f,0.360804945f,0.928664625f,0.992788672f,0.999278069f,0.999927819f,0.266642928f,0.972865343f,-0.7259323f,0.331136763f,0.924909055f,0.99240464f,0.999239624f,0.999923944f,-0.666938066f,0.996578991f,-0.653643608f,0.301137477f,0.921060979f,0.992010653f,0.999200106f,0.999920011f,-0.987339258f,0.921462476f,-0.574823976f,0.270837069f,0.917120814f,0.991606772f,0.999159634f,0.999915957f,-0.399985313f,0.754965007f,-0.49026081f,0.240265846f,0.913088918f,0.991192937f,0.999118149f,0.999911785f,0.555113316f,0.513598084f,-0.400799185f,0.209454387f,0.908965766f,0.990769207f,0.999075651f,0.999907553f,0.999843299f,0.221297964f,-0.307332873f,0.178433478f,0.904751658f,0.990335584f,0.99903214f,0.999903202f,0.52532196f,-0.0929481685f,-0.210795805f,0.147234172f,0.90044713f,0.989892066f,0.998987675f,0.999898732f,-0.432177931f,-0.397976696f,-0.112152524f,0.115887627f,0.89605248f,0.989438653f,0.998942196f,0.999894202f,-0.992335498f,-0.663538098f,-0.0123886634f,0.084425211f,0.891568303f,0.988975346f,0.998895705f,0.999889553f,-0.640144348f,-0.863296807f,0.0874989852f,0.0528783761f,0.886994898f,0.988502085f,0.9988482f,0.999884784f,0.300592542f,-0.977442801f,0.186512366f,0.0212786663f,0.882332861f,0.98801899f,0.998799741f,0.999879956f,0.964965999f,-0.994656384f,0.2836622f,-0.0103423186f,0.87758255f,0.987526f,0.998750269f,0.999875009f,0.742154181f,-0.913230479f,0.377977729f,-0.0419529639f,0.872744501f,0.987023175f,0.998699784f,0.999869943f,-0.162990779f,-0.741239965f,0.468516678f,-0.0735216588f,0.86781919f,0.986510456f,0.998648286f,0.999864817f,-0.918282807f,-0.495741129f,0.554374337f,-0.105016835f,0.862807095f,0.985987842f,0.998595834f,0.999859571f,-0.829309821f,-0.20107992f,0.634692848f,-0.136407003f,0.857708693f,0.985455394f,0.998542368f,0.999854207f,0.0221267566f,0.113522276f,0.708669782f,-0.167660788f,0.852524519f,0.984913111f,0.99848789f,0.999848783f,0.853220105f,0.416866541f,0.775565863f,-0.19874692f,0.847255111f,0.984360933f,0.998432398f,0.99984318f,0.899866819f,0.67887038f,0.834712803f,-0.229634315f,0.841901004f,0.983798921f,0.998375952f,0.999837577f,0.119180135f,0.873551011f,0.885519505f,-0.260292083f,0.836462677f,0.983227074f,0.998318493f,0.999831796f,-0.771080196f,0.981602073f,0.927478433f,-0.290689617f,0.830940664f,0.982645452f,0.998260021f,0.999825954f,-0.952412963f,0.992308259f,0.960170269f,-0.32079646f,0.825335622f,0.982053936f,0.998200536f,0.999819994f,-0.258101642f,0.904607713f,0.98326844f,-0.35058254f,0.819648027f,0.981452644f,0.998140097f,0.999813974f,0.673507154f,0.727197766f,0.996542096f,-0.380018055f,0.813878477f,0.980841517f,0.998078644f,0.999807835f,0.985896587f,0.47767204f,0.999858618f,-0.409073591f,0.808027506f,0.980220556f,0.998016179f,0.999801576f};
__device__ const float ROPE_SIN32[512] = {0.0f,0.0f,0.0f,0.0f,0.0f,0.0f,0.0f,0.0f,0.841470957f,0.310983598f,0.099833414f,0.0316175073f,0.00999983307f,0.00316227227f,0.000999999815f,0.000316227757f,0.909297407f,0.591127098f,0.198669329f,0.0632033944f,0.0199986659f,0.00632451335f,0.0019999987f,0.000632455514f,0.141120002f,0.812648892f,0.295520216f,0.0947260931f,0.029995501f,0.00948669109f,0.0029999956f,0.000948683184f,-0.756802499f,0.953580737f,0.389418334f,0.126154065f,0.0399893336f,0.0126487734f,0.00399998948f,0.00126491068f,-0.958924294f,0.999946535f,0.47942555f,0.157455891f,0.0499791689f,0.0158107299f,0.0049999794f,0.00158113812f,-0.279415488f,0.947148144f,0.564642489f,0.188600287f,0.0599640049f,0.0189725272f,0.0059999642f,0.00189736544f,0.656986594f,0.800421655f,0.64421767f,0.219556093f,0.0699428469f,0.0221341364f,0.00699994294f,0.00221359264f,0.989358246f,0.574317753f,0.717356086f,0.250292361f,0.0799146965f,0.0252955221f,0.0079999147f,0.0025298195f,0.412118495f,0.29125911f,0.783326924f,0.280778348f,0.0898785517f,0.0284566563f,0.00899987854f,0.00284604612f,-0.54402113f,-0.0206835307f,0.841470957f,0.310983598f,0.099833414f,0.0316175073f,0.00999983307f,0.00316227227f,-0.999990225f,-0.330575019f,0.891207337f,0.340877861f,0.1097783f,0.0347780399f,0.0109997783f,0.00347849843f,-0.536572933f,-0.607683539f,0.932039082f,0.370431304f,0.119712204f,0.037938226f,0.0119997123f,0.00379472412f,0.420167029f,-0.824528456f,0.963558197f,0.399614334f,0.129634142f,0.0410980321f,0.0129996343f,0.00411094958f,0.990607381f,-0.959605336f,0.985449731f,0.428397804f,0.139543116f,0.0442574248f,0.0139995422f,0.00442717411f,0.650287867f,-0.999518692f,0.997494996f,0.456752867f,0.149438128f,0.0474163778f,0.0149994371f,0.00474339863f,-0.287903309f,-0.940310359f,0.999573588f,0.484651268f,0.159318209f,0.0505748577f,0.0159993172f,0.00505962269f,-0.961397469f,-0.78785193f,0.991664827f,0.512064993f,0.169182345f,0.053732831f,0.0169991814f,0.00537584629f,-0.750987232f,-0.557262719f,0.973847628f,0.538966775f,0.179029569f,0.0568902642f,0.0179990288f,0.00569206895f,0.149877205f,-0.271410018f,0.946300089f,0.565329552f,0.188858896f,0.060047131f,0.0189988576f,0.00600829162f,0.912945271f,0.0413582139f,0.909297407f,0.591127098f,0.198669329f,0.0632033944f,0.0199986659f,0.00632451335f,0.836655617f,0.350024998f,0.863209367f,0.616333604f,0.208459899f,0.0663590282f,0.0209984574f,0.00664073415f,-0.00885130931f,0.623979986f,0.808496416f,0.640923738f,0.218229622f,0.0695139989f,0.0219982248f,0.00695695495f,-0.846220434f,0.836055219f,0.745705187f,0.664873064f,0.227977529f,0.0726682767f,0.0229979716f,0.00727317436f,-0.905578375f,0.965219319f,0.6754632f,0.688157558f,0.237702623f,0.0758218244f,0.0239976961f,0.0075893933f,-0.132351756f,0.998663187f,0.598472118f,0.710753918f,0.247403964f,0.0789746195f,0.0249973964f,0.00790561177f,0.76255846f,0.933070183f,0.51550138f,0.732639611f,0.257080555f,0.0821266174f,0.0259970706f,0.00822182931f,0.956375957f,0.77494514f,0.427379876f,0.753792763f,0.266731441f,0.0852777958f,0.0269967187f,0.00853804592f,0.270905793f,0.539969206f,0.334988147f,0.774192154f,0.276355654f,0.0884281248f,0.0279963408f,0.0088542616f,-0.663633883f,0.251444817f,0.239249334f,0.793817401f,0.28595221f,0.0915775672f,0.0289959349f,0.00917047635f,-0.988031626f,-0.0620152019f,0.141120002f,0.812648892f,0.295520216f,0.0947260931f,0.029995501f,0.00948669109f,-0.404037654f,-0.369325221f,0.0415806621f,0.830667794f,0.305058628f,0.0978736728f,0.0309950355f,0.00980290398f,0.551426709f,-0.640009463f,-0.0583741441f,0.847856164f,0.314566553f,0.101020269f,0.0319945402f,0.0101191159f,0.999911845f,-0.847224295f,-0.157745689f,0.864196718f,0.324043036f,0.10416586f,0.0329940096f,0.010435327f,0.529082716f,-0.97042042f,-0.255541116f,0.879673123f,0.333487093f,0.107310407f,0.0339934491f,0.010751537f,-0.428182662f,-0.997380435f,-0.350783229f,0.894269943f,0.342897803f,0.110453889f,0.034992855f,0.0110677462f,-0.991778851f,-0.925430834f,-0.44252044f,0.907972574f,0.352274239f,0.113596253f,0.0359922238f,0.0113839535f,-0.643538117f,-0.761706769f,-0.529836118f,0.920767248f,0.361615419f,0.116737492f,0.036991559f,0.0117001608f,0.296368569f,-0.522444665f,-0.611857891f,0.932641327f,0.370920479f,0.119877562f,0.0379908569f,0.0120163662f,0.963795364f,-0.231372029f,-0.687766135f,0.943582773f,0.380188406f,0.123016424f,0.0389901139f,0.0123325698f,0.745113134f,0.0826456547f,-0.756802499f,0.953580737f,0.389418334f,0.126154065f,0.0399893336f,0.0126487734f,-0.158622667f,0.388467401f,-0.818277121f,0.962625206f,0.39860934f,0.129290447f,0.0409885123f,0.0129649751f,-0.916521549f,0.655765057f,-0.871575773f,0.970707119f,0.407760441f,0.132425532f,0.0419876538f,0.0132811759f,-0.831774771f,0.858030856f,-0.916165948f,0.977818429f,0.416870803f,0.135559291f,0.0429867506f,0.0135973748f,0.0177019257f,0.975206256f,-0.951602101f,0.983951986f,0.425939471f,0.138691694f,0.0439858027f,0.0139135728f,0.850903511f,0.995670974f,-0.977530122f,0.989101648f,0.434965521f,0.141822711f,0.0449848138f,0.0142297689f,0.901788354f,0.917395532f,-0.993691027f,0.993262351f,0.44394812f,0.144952312f,0.0459837802f,0.0145459641f,0.123573124f,0.748142481f,-0.999923229f,0.996429801f,0.452886283f,0.148080453f,0.0469826981f,0.0148621574f,-0.768254638f,0.504696608f,-0.99616462f,0.99860096f,0.461779177f,0.151207134f,0.0479815714f,0.0151783498f,-0.953752637f,0.211200237f,-0.982452631f,0.999773562f,0.470625877f,0.15433228f,0.0489803925f,0.0154945403f,-0.262374848f,-0.103240743f,-0.958924294f,0.999946535f,0.47942555f,0.157455891f,0.0499791689f,0.0158107299f,0.670229197f,-0.407443404f,-0.925814688f,0.99911958f,0.48817724f,0.160577938f,0.0509778932f,0.0161269177f,0.986627579f,-0.671240151f,-0.88345468f,0.997293591f,0.496880144f,0.163698375f,0.051976569f,0.0164431036f,0.395925164f,-0.868470371f,-0.832267463f,0.994470417f,0.505533338f,0.166817173f,0.0529751889f,0.0167592876f,-0.558789074f,-0.979574859f,-0.772764504f,0.990652859f,0.514136016f,0.169934288f,0.0539737605f,0.0170754697f,-0.999755144f,-0.993535459f,-0.705540299f,0.985844731f,0.522687256f,0.173049718f,0.0549722761f,0.01739165f,-0.521551013f,-0.908967733f,-0.631266654f,0.980050862f,0.531186223f,0.17616342f,0.0559707358f,0.0177078284f,0.436164767f,-0.734258175f,-0.550685525f,0.973276973f,0.539632022f,0.179275364f,0.0569691397f,0.0180240069f,0.992872655f,-0.486732632f,-0.464602172f,0.965529919f,0.548023939f,0.182385504f,0.0579674877f,0.0183401816f,0.636738002f,-0.190938085f,-0.373876661f,0.956817389f,0.55636102f,0.185493827f,0.0589657761f,0.0186563563f,-0.304810613f,0.123791665f,-0.279415488f,0.947148144f,0.564642489f,0.188600287f,0.0599640049f,0.0189725272f,-0.966117799f,0.426245064f,-0.182162508f,0.936531842f,0.572867453f,0.191704869f,0.0609621778f,0.0192886982f,-0.739180684f,0.68642801f,-0.0830894038f,0.924979091f,0.581035137f,0.194807529f,0.0619602874f,0.0196048655f,0.167355701f,0.878538251f,0.0168139003f,0.912501395f,0.589144766f,0.197908238f,0.0629583374f,0.0199210308f};
__device__ const float ROPE_COS64[1024] = {1.0f,1.0f,1.0f,1.0f,1.0f,1.0f,1.0f,1.0f,1.0f,1.0f,1.0f,1.0f,1.0f,1.0f,1.0f,1.0f,0.540302277f,0.846009135f,0.950415254f,0.98423022f,0.995004177f,0.998419285f,0.999500036f,0.999841869f,0.999949992f,0.999984205f,0.999994993f,0.999998391f,0.999999523f,0.999999821f,0.99999994f,1.0f,-0.416146845f,0.431462824f,0.806578398f,0.937418282f,0.980066597f,0.993682086f,0.998000681f,0.999367595f,0.999800026f,0.999936759f,0.999979973f,0.999993682f,0.999997973f,0.999999344f,0.999999821f,0.99999994f,-0.989992499f,-0.115966141f,0.582753599f,0.861040652f,0.955336511f,0.985803485f,0.995503366f,0.998577297f,0.999550045f,0.999857724f,0.999954998f,0.999985754f,0.99999553f,0.999998569f,0.999999523f,0.999999881f,-0.653643608f,-0.627679646f,0.301137477f,0.757506192f,0.921060979f,0.974808276f,0.992010653f,0.997471273f,0.999200106f,0.999747038f,0.999920011f,0.999974728f,0.999992013f,0.999997497f,0.999999225f,0.999999762f,0.2836622f,-0.946079254f,-0.0103423186f,0.630080283f,0.87758255f,0.960731268f,0.987526f,0.996049762f,0.998750269f,0.999604762f,0.999875009f,0.999960482f,0.999987483f,0.999996066f,0.999998748f,0.999999583f,0.960170269f,-0.973103702f,-0.32079646f,0.482782006f,0.825335622f,0.943616986f,0.982053936f,0.9943133f,0.998200536f,0.999430835f,0.999819994f,0.999943078f,0.999981999f,0.999994338f,0.999998212f,0.999999404f,0.753902256f,-0.700429916f,-0.599437416f,0.320256978f,0.764842212f,0.923519433f,0.975599885f,0.992262423f,0.997551024f,0.999225318f,0.999755025f,0.999922514f,0.999975502f,0.999992251f,0.999997556f,0.999999225f,-0.145500034f,-0.212036505f,-0.818632483f,0.147631198f,0.696706712f,0.900502324f,0.968170285f,0.989897788f,0.996801734f,0.998988271f,0.999680042f,0.999898791f,0.999967992f,0.999989867f,0.999996781f,0.999998987f,-0.91113025f,0.341660321f,-0.956644177f,-0.0296507962f,0.621609986f,0.874638259f,0.959772646f,0.987220109f,0.995952725f,0.998719573f,0.999595046f,0.99987191f,0.999959528f,0.999987185f,0.999995947f,0.999998748f,-0.839071512f,0.790131986f,-0.999786079f,-0.205997616f,0.540302277f,0.846009135f,0.950415254f,0.98423022f,0.995004177f,0.998419285f,0.999500036f,0.999841869f,0.999949992f,0.999984205f,0.999994993f,0.999998391f,0.00442569796f,0.995257378f,-0.943779707f,-0.375847369f,0.453596115f,0.814705312f,0.940107584f,0.980929136f,0.993956089f,0.998087406f,0.999395072f,0.999808669f,0.999939501f,0.999980867f,0.99999392f,0.999998093f,0.843853951f,0.893861651f,-0.794179261f,-0.5338431f,0.362357765f,0.780825913f,0.92885989f,0.97731787f,0.99280864f,0.997723997f,0.999280095f,0.99977231f,0.999927998f,0.999977231f,0.999992788f,0.999997735f,0.907446802f,0.517172813f,-0.565820515f,-0.675001621f,0.267498821f,0.744477987f,0.916683376f,0.973397553f,0.99156189f,0.997329056f,0.999155104f,0.999732792f,0.999915481f,0.999973297f,0.999991536f,0.999997318f,0.136737213f,-0.0187958125f,-0.281349629f,-0.794870913f,0.169967145f,0.705776393f,0.903590262f,0.969169438f,0.990216017f,0.996902585f,0.999020159f,0.999690115f,0.99990201f,0.999969006f,0.999990225f,0.999996901f,-0.759687901f,-0.548975706f,0.0310225319f,-0.889670372f,0.070737198f,0.664843559f,0.889593601f,0.964634836f,0.988771081f,0.996444523f,0.998875201f,0.999644279f,0.999887526f,0.999964416f,0.999988735f,0.999996424f,-0.957659483f,-0.910081029f,0.340318203f,-0.95641005f,-0.029199522f,0.621808827f,0.87470746f,0.959795177f,0.987227261f,0.99595499f,0.998720288f,0.999595284f,0.999872029f,0.999959528f,0.999987185f,0.999995947f,-0.275163352f,-0.990898013f,0.615864694f,-0.99298501f,-0.1288445f,0.576808274f,0.858946681f,0.954652011f,0.985584795f,0.995433986f,0.998555362f,0.999543071f,0.999855518f,0.999954283f,0.999985576f,0.99999541f,0.660316706f,-0.766536474f,0.830336273f,-0.998241663f,-0.227202088f,0.529984236f,0.842327058f,0.949207008f,0.983843684f,0.994881511f,0.998380423f,0.999487758f,0.999837995f,0.9999488f,0.999983788f,0.999994874f,0.988704622f,-0.30609566f,0.962463796f,-0.972014248f,-0.323289573f,0.481484622f,0.824865103f,0.943461835f,0.982004225f,0.994297504f,0.998195529f,0.999429286f,0.999819517f,0.999942899f,0.99998194f,0.999994278f,0.408082068f,0.248617053f,0.999144375f,-0.91512996f,-0.416146845f,0.431462824f,0.806578398f,0.937418282f,0.980066597f,0.993682086f,0.998000681f,0.999367595f,0.999800026f,0.999936759f,0.999979973f,0.999993682f,-0.547729254f,0.726760209f,0.936740339f,-0.829382896f,-0.504846096f,0.380077004f,0.787485182f,0.931078374f,0.97803092f,0.993035257f,0.99779582f,0.999302804f,0.999779522f,0.999930263f,0.999977946f,0.999993026f,-0.99996084f,0.981074512f,0.781440318f,-0.7174775f,-0.588501096f,0.327489585f,0.76760453f,0.92444396f,0.975897431f,0.992357016f,0.997581005f,0.999234855f,0.999758005f,0.999923468f,0.999975801f,0.999992371f,-0.53283304f,0.933235705f,0.548645318f,-0.582943201f,-0.666276038f,0.273866832f,0.746956348f,0.917517304f,0.97366637f,0.991647422f,0.997356176f,0.999163687f,0.999735534f,0.999916375f,0.999973536f,0.999991655f,0.424179018f,0.597977281f,0.26144141f,-0.430023134f,-0.737393737f,0.219378248f,0.725561321f,0.910300434f,0.971337974f,0.990906477f,0.997121394f,0.99908942f,0.99971199f,0.999908924f,0.999971211f,0.99999088f,0.991202831f,0.0785527974f,-0.051689472f,-0.263540328f,-0.801143587f,0.164196119f,0.703440726f,0.902795732f,0.968912423f,0.99013412f,0.996876657f,0.999011934f,0.999687493f,0.999901175f,0.999968767f,0.999990106f,0.64691931f,-0.465064526f,-0.359694332f,-0.0887456089f,-0.856888771f,0.108494893f,0.680616736f,0.895005584f,0.966389954f,0.98933053f,0.996621907f,0.998931348f,0.999662042f,0.999893129f,0.999966204f,0.999989331f,-0.292138815f,-0.865450501f,-0.63202852f,0.088848114f,-0.904072165f,0.0524506681f,0.657112241f,0.886932373f,0.963770926f,0.988495648f,0.996357203f,0.998847544f,0.999635518f,0.999884725f,0.999963522f,0.999988496f,-0.962605894f,-0.999293447f,-0.841684759f,0.263639599f,-0.942222357f,-0.00375937484f,0.632950664f,0.878578722f,0.961055458f,0.987629473f,0.996082544f,0.998760641f,0.99960804f,0.999876022f,0.99996078f,0.999987602f,-0.748057544f,-0.825372219f,-0.967871606f,0.430116028f,-0.970958173f,-0.0599575341f,0.608156204f,0.869947255f,0.958243847f,0.986732066f,0.995797932f,0.998670578f,0.999579549f,0.999867022f,0.999957979f,0.999986708f,0.154251456f,-0.397251397f,-0.998075187f,0.583026826f,-0.989992499f,-0.115966141f,0.582753599f,0.861040652f,0.955336511f,0.985803485f,0.995503366f,0.998577297f,0.999550045f,0.999857724f,0.999954998f,0.999985754f,0.914742351f,0.153215602f,-0.929300189f,0.717549205f,-0.999135137f,-0.171608135f,0.556768298f,0.851861775f,0.95233357f,0.984843671f,0.995198846f,0.998480916f,0.999519527f,0.999848068f,0.999951959f,0.999984801f,0.83422339f,0.656494975f,-0.768367052f,0.829440415f,-0.998294771f,-0.226707578f,0.53022635f,0.842413545f,0.949235439f,0.983852804f,0.994884372f,0.998381376f,0.999488056f,0.999838114f,0.9999488f,0.999983788f,-0.0132767474f,0.957585931f,-0.531235337f,0.915171444f,-0.987479746f,-0.281090319f,0.503154159f,0.832698941f,0.946042359f,0.982830763f,0.994559944f,0.998278618f,0.999455571f,0.999827802f,0.999945521f,0.999982774f,-0.848570287f,0.963757813f,-0.241421327f,0.972038448f,-0.966798186f,-0.334584415f,0.475578845f,0.822721004f,0.942754686f,0.981777668f,0.994225562f,0.99817276f,0.999422073f,0.999817252f,0.999942183f,0.999981701f,-0.903692186f,0.673109829f,0.072334297f,0.998247743f,-0.93645668f,-0.387020707f,0.447528005f,0.812482893f,0.939372718f,0.980693519f,0.993881226f,0.998063743f,0.999387562f,0.999806345f,0.999938726f,0.999980628f,-0.127963692f,0.175156325f,0.378916562f,0.992972851f,-0.896758437f,-0.438233495f,0.419029653f,0.801987886f,0.935896814f,0.979578316f,0.993526995f,0.997951567f,0.999352098f,0.999795079f,0.99993521f,0.999979496f,0.765414059f,-0.376742154f,0.64792192f,0.95638001f,-0.848100007f,-0.488060802f,0.39011234f,0.791239262f,0.93232733f,0.978432178f,0.993162811f,0.997836173f,0.99931556f,0.999783576f,0.999931574f,0.999978364f,0.955073655f,-0.812610924f,0.852673173f,0.889623404f,-0.790967703f,-0.536345124f,0.360804945f,0.780240476f,0.928664625f,0.977255106f,0.992788672f,0.997717679f,0.999278069f,0.999771714f,0.999927819f,0.999977171f,0.266642928f,-0.998210311f,0.972865343f,0.794808507f,-0.7259323f,-0.582933843f,0.331136763f,0.768994868f,0.924909055f,0.976047099f,0.99240464f,0.997596025f,0.999239624f,0.999759495f,0.999923944f,0.999975979f,-0.666938066f,-0.876379132f,0.996578991f,0.674925685f,-0.653643608f,-0.627679646f,0.301137477f,0.757506192f,0.921060979f,0.974808276f,0.992010653f,0.997471273f,0.999200106f,0.999747038f,0.999920011f,0.999974728f,-0.987339258f,-0.484639138f,0.921462476f,0.533756077f,-0.574823976f,-0.670441091f,0.270837069f,0.745777905f,0.917120814f,0.973538578f,0.991606772f,0.997343302f,0.999159634f,0.999734223f,0.999915957f,0.999973416f,-0.399985313f,0.0563608743f,0.754965007f,0.375752002f,-0.49026081f,-0.711082935f,0.240265846f,0.733813822f,0.913088918f,0.972238123f,0.991192937f,0.997212172f,0.999118149f,0.99972111f,0.999911785f,0.999972105f,0.555113316f,0.580002785f,0.513598084f,0.205896914f,-0.400799185f,-0.74947679f,0.209454387f,0.721617699f,0.908965766f,0.970906913f,0.990769207f,0.997077882f,0.999075651f,0.999707639f,0.999907553f,0.999970794f,0.999843299f,0.925014377f,0.221297964f,0.0295479279f,-0.307332873f,-0.785501122f,0.178433478f,0.709193349f,0.904751658f,0.969545007f,0.990335584f,0.996940494f,0.99903214f,0.99969393f,0.999903202f,0.999969363f,0.52532196f,0.985138416f,-0.0929481685f,-0.147732988f,-0.210795805f,-0.819042206f,0.147234172f,0.696544766f,0.90044713f,0.968152463f,0.989892066f,0.996799886f,0.998987675f,0.999679863f,0.999898732f,0.999967992f,-0.432177931f,0.741857767f,-0.397976696f,-0.320354462f,-0.112152524f,-0.849993944f,0.115887627f,0.683675885f,0.89605248f,0.966729224f,0.989438653f,0.996656179f,0.998942196f,0.999665439f,0.999894202f,0.999966562f,-0.992335498f,0.270098448f,-0.663538098f,-0.482872128f,-0.0123886634f,-0.878258407f,0.084425211f,0.670590878f,0.891568303f,0.965275466f,0.988975346f,0.996509314f,0.998895705f,0.999650776f,0.999889553f,0.999965072f,-0.640144348f,-0.284846276f,-0.863296807f,-0.630160213f,0.0874989852f,-0.903746367f,0.0528783761f,0.657293797f,0.886994898f,0.963791192f,0.988502085f,0.996359289f,0.9988482f,0.999635756f,0.999884784f,0.999963582f,0.300592542f,-0.752063513f,-0.977442801f,-0.757573366f,0.186512366f,-0.926377177f,0.0212786663f,0.643788815f,0.882332861f,0.962276459f,0.98801899f,0.996206105f,0.998799741f,0.999620378f,0.999879956f,0.999962032f,0.964965999f,-0.987658918f,-0.994656384f,-0.861092985f,0.2836622f,-0.946079254f,-0.0103423186f,0.630080283f,0.87758255f,0.960731268f,0.987526f,0.996049762f,0.998750269f,0.999604762f,0.999875009f,0.999960482f,0.742154181f,-0.919073343f,-0.913230479f,-0.937454164f,0.377977729f,-0.96279037f,-0.0419529639f,0.616172552f,0.872744501f,0.959155679f,0.987023175f,0.99589026f,0.998699784f,0.999588788f,0.999869943f,0.999958873f,-0.162990779f,-0.56742996f,-0.741239965f,-0.984248459f,0.468516678f,-0.976457715f,-0.0735216588f,0.602069914f,0.86781919f,0.95754981f,0.986510456f,0.995727658f,0.998648286f,0.999572515f,0.999864817f,0.999957263f,-0.918282807f,-0.0410284549f,-0.495741129f,-1.0f,0.554374337f,-0.987038016f,-0.105016835f,0.587776899f,0.862807095f,0.955913603f,0.985987842f,0.995561838f,0.998595834f,0.999555886f,0.999859571f,0.999955595f,-0.829309821f,0.498009056f,-0.20107992f,-0.984212041f,0.634692848f,-0.994497836f,-0.136407003f,0.573298037f,0.857708693f,0.954247177f,0.985455394f,0.995392919f,0.998542368f,0.999538958f,0.999854207f,0.999953866f,0.0221267566f,0.88366884f,0.113522276f,-0.93738246f,0.708669782f,-0.998813629f,-0.167660788f,0.558637917f,0.852524519f,0.95255059f,0.984913111f,0.99522084f,0.99848789f,0.999521732f,0.999848783f,0.999952197f,0.853220105f,0.99717474f,0.416866541f,-0.860988319f,0.775565863f,-0.999971747f,-0.19874692f,0.543801129f,0.847255111f,0.950823903f,0.984360933f,0.995045662f,0.998432398f,0.999504209f,0.99984318f,0.999950409f,0.899866819f,0.803568959f,0.67887038f,-0.757438958f,0.834712803f,-0.997968495f,-0.229634315f,0.528792322f,0.841901004f,0.949067116f,0.983798921f,0.994867265f,0.998375952f,0.999486327f,0.999837577f,0.999948621f,0.119180135f,0.362478614f,0.873551011f,-0.630000412f,0.885519505f,-0.99281019f,-0.260292083f,0.513616383f,0.836462677f,0.947280347f,0.983227074f,0.994685769f,0.998318493f,0.999468148f,0.999831796f,0.999946833f,-0.771080196f,-0.190248564f,0.981602073f,-0.482691884f,0.927478433f,-0.984513164f,-0.290689617f,0.498277962f,0.830940664f,0.945463598f,0.982645452f,0.994501114f,0.998260021f,0.99944967f,0.999825954f,0.999944985f,-0.952412963f,-0.684382617f,0.992308259f,-0.320159495f,0.960170269f,-0.973103702f,-0.32079646f,0.482782006f,0.825335622f,0.943616986f,0.982053936f,0.9943133f,0.998200536f,0.999430835f,0.999819994f,0.999943078f,-0.258101642f,-0.967739344f,0.904607713f,-0.147529408f,0.98326844f,-0.958617806f,-0.35058254f,0.467133373f,0.819648027f,0.941740453f,0.981452644f,0.994122326f,0.998140097f,0.999411702f,0.999813974f,0.99994117f,0.673507154f,-0.953049958f,0.727197766f,0.0297536626f,0.996542096f,-0.941101313f,-0.380018055f,0.451337039f,0.813878477f,0.939834237f,0.980841517f,0.993928254f,0.998078644f,0.999392271f,0.999807835f,0.999939203f,0.985896587f,-0.644838572f,0.47767204f,0.206098318f,0.999858618f,-0.920609534f,-0.409073591f,0.435397953f,0.808027506f,0.937898219f,0.980220556f,0.993731022f,0.998016179f,0.999372482f,0.999801576f,0.999937236f};
__device__ const float ROPE_SIN64[1024] = {0.0f,0.0f,0.0f,0.0f,0.0f,0.0f,0.0f,0.0f,0.0f,0.0f,0.0f,0.0f,0.0f,0.0f,0.0f,0.0f,0.841470957f,0.533168435f,0.310983598f,0.176892191f,0.099833414f,0.0562044978f,0.0316175073f,0.0177818574f,0.00999983307f,0.00562338345f,0.00316227227f,0.0017782785f,0.000999999815f,0.000562341302f,0.000316227757f,0.00017782794f,0.909297407f,0.902130723f,0.591127098f,0.348205268f,0.198669329f,0.112231314f,0.0632033944f,0.0355580896f,0.0199986659f,0.011246589f,0.00632451335f,0.00355655141f,0.0019999987f,0.00112468237f,0.000632455514f,0.00035565588f,0.141120002f,0.993253171f,0.812648892f,0.50853616f,0.295520216f,0.167903304f,0.0947260931f,0.0533230789f,0.029995501f,0.0168694388f,0.00948669109f,0.00533481315f,0.0029999956f,0.00168702321f,0.000948683184f,0.000533483806f,-0.756802499f,0.778471768f,0.953580737f,0.652827978f,0.389418334f,0.223044485f,0.126154065f,0.0710712075f,0.0399893336f,0.0224917568f,0.0126487734f,0.00711305765f,0.00399998948f,0.00224936334f,0.00126491068f,0.000711311703f,-0.958924294f,0.323935211f,0.999946535f,0.776529968f,0.47942555f,0.277480543f,0.157455891f,0.0887968615f,0.0499791689f,0.0281133614f,0.0158107299f,0.00889127981f,0.0049999794f,0.0028117029f,0.00158113812f,0.000889139599f,-0.279415488f,-0.230367482f,0.947148144f,0.875740588f,0.564642489f,0.331039339f,0.188600287f,0.106494434f,0.0599640049f,0.0337340795f,0.0189725272f,0.0106694736f,0.0059999642f,0.00337404152f,0.00189736544f,0.0010669675f,0.656986594f,-0.713721156f,0.800421655f,0.947330713f,0.64421767f,0.383551568f,0.219556093f,0.124158338f,0.0699428469f,0.0393537283f,0.0221341364f,0.0124476347f,0.00699994294f,0.00393637922f,0.00221359264f,0.00124479528f,0.989358246f,-0.977261722f,0.574317753f,0.989042461f,0.717356086f,0.434851229f,0.250292361f,0.141782969f,0.0799146965f,0.0449721329f,0.0252955221f,0.0142257558f,0.0079999147f,0.00449871551f,0.0025298195f,0.00142262306f,0.412118495f,-0.939823508f,0.29125911f,0.999560297f,0.783326924f,0.484776139f,0.280778348f,0.159362778f,0.0898785517f,0.0505891144f,0.0284566563f,0.0160038322f,0.00899987854f,0.00506105041f,0.00284604612f,0.00160045084f,-0.54402113f,-0.612936735f,-0.0206835307f,0.97855252f,0.841470957f,0.533168435f,0.310983598f,0.176892191f,0.099833414f,0.0562044978f,0.0316175073f,0.0177818574f,0.00999983307f,0.00562338345f,0.00316227227f,0.0017782785f,-0.999990225f,-0.0972766578f,-0.330575019f,0.926681578f,0.891207337f,0.579875171f,0.340877861f,0.194365665f,0.1097783f,0.0618181042f,0.0347780399f,0.0195598267f,0.0109997783f,0.00618571509f,0.00347849843f,0.00195610616f,-0.536572933f,0.44834289f,-0.607683539f,0.845583558f,0.932039082f,0.624748647f,0.370431304f,0.211777672f,0.119712204f,0.0674297586f,0.037938226f,0.0213377327f,0.0119997123f,0.00674804486f,0.00379472412f,0.00213393359f,0.420167029f,0.855880976f,-0.824528456f,0.737816215f,0.963558197f,0.667647004f,0.399614334f,0.229122713f,0.129634142f,0.0730392784f,0.0410980321f,0.0231155735f,0.0129996343f,0.00731037231f,0.00411094958f,0.00231176126f,0.990607381f,0.999823332f,-0.959605336f,0.606778562f,0.985449731f,0.708434701f,0.428397804f,0.246395305f,0.139543116f,0.078646481f,0.0442574248f,0.0248933397f,0.0139995422f,0.00787269697f,0.00442717411f,0.00248958869f,0.650287867f,0.835838318f,-0.999518692f,0.456603318f,0.997494996f,0.746982634f,0.456752867f,0.263589978f,0.149438128f,0.0842512026f,0.0474163778f,0.0266710278f,0.0149994371f,0.00843502022f,0.00474339863f,0.00266741589f,-0.287903309f,0.41443032f,-0.940310359f,0.292027056f,0.999573588f,0.783169091f,0.484651268f,0.280701309f,0.159318209f,0.0898532644f,0.0505748577f,0.028448632f,0.0159993172f,0.00899733976f,0.00505962269f,0.00284524332f,-0.961397469f,-0.134614661f,-0.78785193f,0.118240394f,0.991664827f,0.81687957f,0.512064993f,0.29772386f,0.169182345f,0.09545248f,0.053732831f,0.0302261449f,0.0169991814f,0.00955965649f,0.00537584629f,0.00302307028f,-0.750987232f,-0.642200768f,-0.557262719f,-0.0592755191f,0.973847628f,0.8480075f,0.538966775f,0.314652264f,0.179029569f,0.101048678f,0.0568902642f,0.0320035629f,0.0179990288f,0.0101219714f,0.00569206895f,0.00320089748f,0.149877205f,-0.952000737f,-0.271410018f,-0.234921902f,0.946300089f,0.876454532f,0.565329552f,0.331481189f,0.188858896f,0.10664168f,0.060047131f,0.0337808803f,0.0189988576f,0.0106842816f,0.00600829162f,0.00337872445f,0.912945271f,-0.968601882f,0.0413582139f,-0.403158963f,0.909297407f,0.902130723f,0.591127098f,0.348205268f,0.198669329f,0.112231314f,0.0632033944f,0.0355580896f,0.0199986659f,0.011246589f,0.00632451335f,0.00355655141f,0.836655617f,-0.686891258f,0.350024998f,-0.558680594f,0.863209367f,0.924954832f,0.616333604f,0.364819258f,0.208459899f,0.117817394f,0.0663590282f,0.0373351872f,0.0209984574f,0.0118088936f,0.00664073415f,0.00373437814f,-0.00885130931f,-0.193630621f,0.623979986f,-0.696581662f,0.808496416f,0.944854796f,0.640923738f,0.381317884f,0.218229622f,0.123399749f,0.0695139989f,0.0391121693f,0.0219982248f,0.0123711936f,0.00695695495f,0.00391220488f,-0.846220434f,0.359264702f,0.836055219f,-0.812512934f,0.745705187f,0.961767614f,0.664873064f,0.397695929f,0.227977529f,0.128978208f,0.0726682767f,0.0408890247f,0.0229979716f,0.0129334899f,0.00727317436f,0.00409003114f,-0.905578375f,0.801513016f,0.965219319f,-0.902817845f,0.6754632f,0.97563988f,0.688157558f,0.413948208f,0.237702623f,0.134552568f,0.0758218244f,0.0426657498f,0.0239976961f,0.0134957824f,0.0075893933f,0.00426785741f,-0.132351756f,0.996909976f,0.998663187f,-0.964648366f,0.598472118f,0.986427724f,0.710753918f,0.430069596f,0.247403964f,0.140122697f,0.0789746195f,0.0444423407f,0.0249973964f,0.0140580703f,0.00790561177f,0.00444568368f,0.76255846f,0.885276794f,0.933070183f,-0.996054351f,0.51550138f,0.994096994f,0.732639611f,0.446054965f,0.257080555f,0.145688385f,0.0821266174f,0.0462187938f,0.0259970706f,0.0146203535f,0.00822182931f,0.00462350994f,0.956375957f,0.500994503f,0.77494514f,-0.996045172f,0.427379876f,0.99862349f,0.753792763f,0.46189931f,0.266731441f,0.151249468f,0.0852777958f,0.0479950979f,0.0269967187f,0.015182632f,0.00853804592f,0.00480133574f,0.270905793f,-0.0375849828f,0.539969206f,-0.964621246f,0.334988147f,0.999992907f,0.774192154f,0.477597594f,0.276355654f,0.156805769f,0.0884281248f,0.049771253f,0.0279963408f,0.0157449059f,0.0088542616f,0.00497916155f,-0.663633883f,-0.564588964f,0.251444817f,-0.902773619f,0.239249334f,0.998200953f,0.793817401f,0.49314484f,0.28595221f,0.162357107f,0.0915775672f,0.0515472479f,0.0289959349f,0.0163071752f,0.00917047635f,0.00515698735f,-0.988031626f,-0.917709827f,-0.0620152019f,-0.812452912f,0.141120002f,0.993253171f,0.812648892f,0.50853616f,0.295520216f,0.167903304f,0.0947260931f,0.0533230789f,0.029995501f,0.0168694388f,0.00948669109f,0.00533481315f,-0.404037654f,-0.988192797f,-0.369325221f,-0.696507812f,0.0415806621f,0.985165298f,0.830667794f,0.523766637f,0.305058628f,0.173444211f,0.0978736728f,0.055098746f,0.0309950355f,0.0174316987f,0.00980290398f,0.00551263802f,0.551426709f,-0.754330397f,-0.640009463f,-0.55859524f,-0.0583741441f,0.973962843f,0.847856164f,0.538831532f,0.314566553f,0.17897962f,0.101020269f,0.0568742342f,0.0319945402f,0.0179939512f,0.0101191159f,0.00569046335f,0.999911845f,-0.288147956f,-0.847224295f,-0.403064787f,-0.157745689f,0.959681332f,0.864196718f,0.553725958f,0.324043036f,0.184509367f,0.10416586f,0.0586495437f,0.0329940096f,0.0185561981f,0.010435327f,0.00586828822f,0.529082716f,0.266778797f,-0.97042042f,-0.234821871f,-0.255541116f,0.942365766f,0.879673123f,0.568445385f,0.333487093f,0.190033287f,0.107310407f,0.0604246706f,0.0339934491f,0.0191184394f,0.010751537f,0.00604611309f,-0.428182662f,0.739542544f,-0.997380435f,-0.0591727868f,-0.350783229f,0.92207104f,0.894269943f,0.582984984f,0.342897803f,0.195551187f,0.110453889f,0.0621996038f,0.034992855f,0.0196806751f,0.0110677462f,0.00622393796f,-0.991778851f,0.984540641f,-0.925430834f,0.118342586f,-0.44252044f,0.89886117f,0.907972574f,0.597340286f,0.352274239f,0.201062918f,0.113596253f,0.0639743432f,0.0359922238f,0.0202429052f,0.0113839535f,0.00640176237f,-0.643538117f,0.926318169f,-0.761706769f,0.292125493f,-0.529836118f,0.872809649f,0.920767248f,0.611506641f,0.361615419f,0.206568286f,0.116737492f,0.0657488778f,0.036991559f,0.0208051279f,0.0117001608f,0.0065795863f,0.296368569f,0.582806587f,-0.522444665f,0.456694871f,-0.611857891f,0.84399873f,0.932641327f,0.625479698f,0.370920479f,0.212067112f,0.119877562f,0.0675232038f,0.0379908569f,0.021367345f,0.0120163662f,0.00675741024f,0.963795364f,0.0598011911f,-0.231372029f,0.60686034f,-0.687766135f,0.81251961f,0.943582773f,0.639254928f,0.380188406f,0.217559248f,0.123016424f,0.0692973137f,0.0389901139f,0.0219295528f,0.0123325698f,0.00693523418f,0.745113134f,-0.481621891f,0.0826456547f,0.737885714f,-0.756802499f,0.778471768f,0.953580737f,0.652827978f,0.389418334f,0.223044485f,0.126154065f,0.0710712075f,0.0399893336f,0.0224917568f,0.0126487734f,0.00711305765f,-0.158622667f,-0.874714196f,0.388467401f,0.845638514f,-0.818277121f,0.74196279f,0.962625206f,0.666194677f,0.39860934f,0.228522688f,0.129290447f,0.0728448778f,0.0409885123f,0.0230539516f,0.0129649751f,0.00729088113f,-0.916521549f,-0.998410463f,0.655765057f,0.926720262f,-0.871575773f,0.703108132f,0.970707119f,0.679350615f,0.407760441f,0.233993649f,0.132425532f,0.0746183172f,0.0419876538f,0.0236161407f,0.0132811759f,0.00746870413f,-0.831774771f,-0.814614534f,0.858030856f,0.97857368f,-0.916165948f,0.662030637f,0.977818429f,0.692291796f,0.416870803f,0.23945722f,0.135559291f,0.0763915181f,0.0429867506f,0.0241783205f,0.0135973748f,0.00764652714f,0.0177019257f,-0.379932135f,0.975206256f,0.999563336f,-0.951602101f,0.618860185f,0.983951986f,0.70501405f,0.425939471f,0.24491322f,0.138691694f,0.0781644806f,0.0439858027f,0.0247404929f,0.0139135728f,0.00782434922f,0.850903511f,0.171762422f,0.995670974f,0.989027262f,-0.977530122f,0.57373327f,0.989101648f,0.717513323f,0.434965521f,0.250361472f,0.141822711f,0.0799371973f,0.0449848138f,0.0253026597f,0.0142297689f,0.00800217222f,0.901788354f,0.670557261f,0.917395532f,0.947297752f,-0.993691027f,0.526792467f,0.993262351f,0.72978574f,0.44394812f,0.255801797f,0.144952312f,0.0817096531f,0.0459837802f,0.0258648153f,0.0145459641f,0.0081799943f,0.123573124f,0.962832689f,0.748142481f,0.875690877f,-0.999923229f,0.47818628f,0.996429801f,0.741827369f,0.452886283f,0.261234045f,0.148080453f,0.0834818631f,0.0469826981f,0.0264269654f,0.0148621574f,0.00835781638f,-0.768254638f,0.958573222f,0.504696608f,0.776465118f,-0.99616462f,0.42806834f,0.99860096f,0.753634453f,0.461779177f,0.266658038f,0.151207134f,0.0852537975f,0.0479815714f,0.0269891061f,0.0151783498f,0.00853563752f,-0.953752637f,0.659090638f,0.211200237f,0.652750015f,-0.982452631f,0.376597077f,0.999773562f,0.765203178f,0.470625877f,0.272073597f,0.15433228f,0.087025471f,0.0489803925f,0.0275512375f,0.0154945403f,0.00871345866f,-0.262374848f,0.156620145f,-0.103240743f,0.508447528f,-0.958924294f,0.323935211f,0.999946535f,0.776529968f,0.47942555f,0.277480543f,0.157455891f,0.0887968615f,0.0499791689f,0.0281133614f,0.0158107299f,0.00889127981f,0.670229197f,-0.39408651f,-0.407443404f,0.348108798f,-0.925814688f,0.270249248f,0.99911958f,0.787611187f,0.48817724f,0.282878697f,0.160577938f,0.0905679762f,0.0509778932f,0.0286754761f,0.0161269177f,0.00906910095f,0.986627579f,-0.823421657f,-0.671240151f,0.176790893f,-0.88345468f,0.215708897f,0.997293591f,0.798443377f,0.496880144f,0.28826794f,0.163698375f,0.0923388004f,0.051976569f,0.0292375814f,0.0164431036f,0.00924692117f,0.395925164f,-0.999157965f,-0.868470371f,-0.00010291244f,-0.832267463f,0.160486609f,0.994470417f,0.809023023f,0.505533338f,0.293648034f,0.166817173f,0.0941093415f,0.0529751889f,0.0297996774f,0.0167592876f,0.00942474138f,-0.558789074f,-0.867171824f,-0.979574859f,-0.176993474f,-0.772764504f,0.104756944f,0.990652859f,0.819346905f,0.514136016f,0.29901886f,0.169934288f,0.0958795771f,0.0539737605f,0.0303617641f,0.0170754697f,0.00960256159f,-0.999755144f,-0.468112558f,-0.993535459f,-0.348301739f,-0.705540299f,0.0486961007f,0.985844731f,0.829411626f,0.522687256f,0.304380238f,0.173049718f,0.0976495072f,0.0549722761f,0.0309238415f,0.01739165f,0.00978038087f,-0.521551013f,0.0751168504f,-0.908967733f,-0.508624732f,-0.631266654f,-0.0075186966f,0.980050862f,0.839214146f,0.531186223f,0.30973199f,0.17616342f,0.0994191319f,0.0559707358f,0.0314859077f,0.0177078284f,0.00995820016f,0.436164767f,0.595211625f,-0.734258175f,-0.652905941f,-0.550685525f,-0.063709721f,0.973276973f,0.848751247f,0.539632022f,0.315073937f,0.179275364f,0.101188444f,0.0569691397f,0.0320479684f,0.0180240069f,0.0101360194f,0.992872655f,0.931992114f,-0.486732632f,-0.776594818f,-0.464602172f,-0.119699337f,0.965529919f,0.858019948f,0.548023939f,0.32040593f,0.182385504f,0.102957435f,0.0579674877f,0.0326100141f,0.0183401816f,0.0103138378f,0.636738002f,0.981735945f,-0.190938085f,-0.875790238f,-0.373876661f,-0.175310522f,0.956817389f,0.867017329f,0.55636102f,0.325727791f,0.185493827f,0.104726106f,0.0589657761f,0.0331720524f,0.0186563563f,0.0104916561f,-0.304810613f,0.729123056f,0.123791665f,-0.947363675f,-0.279415488f,-0.230367482f,0.947148144f,0.875740588f,0.564642489f,0.331039339f,0.188600287f,0.106494434f,0.0599640049f,0.0337340795f,0.0189725272f,0.0106694736f,-0.966117799f,0.251953512f,0.426245064f,-0.98905766f,-0.182162508f,-0.284696132f,0.936531842f,0.884186864f,0.572867453f,0.336340427f,0.191704869f,0.108262435f,0.0609621778f,0.0342960954f,0.0192886982f,0.0108472919f,-0.739180684f,-0.302813113f,0.68642801f,-0.999557257f,-0.0830894038f,-0.338124752f,0.924979091f,0.892353535f,0.581035137f,0.341630876f,0.194807529f,0.110030092f,0.0619602874f,0.0348581001f,0.0196048655f,0.0110251093f,0.167355701f,-0.764318824f,0.878538251f,-0.978531301f,0.0168139003f,-0.390484393f,0.912501395f,0.900238097f,0.589144766f,0.346910506f,0.197908238f,0.1117974f,0.0629583374f,0.0354200937f,0.0199210308f,0.0112029258f};


__device__ __forceinline__ unsigned cvt_pk_bf16(float lo, float hi) { unsigned r; asm volatile("v_cvt_pk_bf16_f32 %0, %1, %2" : "=v"(r) : "v"(lo), "v"(hi)); return r; }
__device__ __forceinline__ float bf_lo(unsigned u) { return __uint_as_float(u << 16); }
__device__ __forceinline__ float bf_hi(unsigned u) { return __uint_as_float(u & 0xffff0000u); }
__device__ __forceinline__ float bf1(bf16_t u) { return __uint_as_float((unsigned)u << 16); }
__device__ __forceinline__ float fast_exp2(float x) { return __builtin_amdgcn_exp2f(x); }
__device__ __forceinline__ float wave_sum(float v) {
#pragma unroll
    for (int o = 1; o < 64; o <<= 1) v += __shfl_xor(v, o);
    return v;
}
#define LDS_WAIT() asm volatile("s_waitcnt lgkmcnt(0)" ::: "memory")

#define XB_TMO      128
#define XB_XCNT(j)  (256  + 64 * (j))
#define XB_XSUB(j)  (1280 + 64 * (j))
#define XB_XGEN(j)  (2304 + 64 * (j))
#define XB_TOP      3328
#define XB_TOPGEN   3392
#define XCD_BAR_WORDS 3456
#define XB_SPIN_CAP (1u << 18)
__device__ __forceinline__ unsigned xb_ld(unsigned* p)              { return __hip_atomic_load(p, __ATOMIC_RELAXED, __HIP_MEMORY_SCOPE_AGENT); }
__device__ __forceinline__ unsigned xb_add(unsigned* p, unsigned v) { return __hip_atomic_fetch_add(p, v, __ATOMIC_RELAXED, __HIP_MEMORY_SCOPE_AGENT); }
__device__ __forceinline__ unsigned xb_xcc_id() { return (unsigned)__builtin_amdgcn_s_getreg((3 << 11) | 20) & 0xFu; }
#define XB_SPIN(cond, bar) do { unsigned _sp = 0; while (cond) { __builtin_amdgcn_s_sleep(1); \
    if ((++_sp & 255u) == 0u) { if (xb_ld(&(bar)[XB_TMO])) break; if (_sp > XB_SPIN_CAP) { atomicAdd(&(bar)[XB_TMO], 1u); break; } } } } while (0)
struct XcdBarrier { unsigned* bar; unsigned x; volatile LAS unsigned* st; };
__device__ __forceinline__ XcdBarrier xcd_barrier_post(unsigned* bar, volatile LAS unsigned* st) {
    XcdBarrier b; b.bar = bar; b.x = xb_xcc_id(); b.st = st;
    if (threadIdx.x == 0) (void)xb_add(&bar[XB_XCNT(b.x)], 1u);
    return b;
}
__device__ __forceinline__ void xcd_barrier_complete(unsigned* bar, unsigned x, unsigned& nloc, unsigned& nx) {
    const unsigned G = gridDim.x * gridDim.y * gridDim.z;
    unsigned sum, cnt, mine, sp = 0u;
    for (;;) {
        sum = 0u; cnt = 0u; mine = 0u;
#pragma unroll
        for (unsigned j = 0; j < 16; ++j) { const unsigned c = xb_ld(&bar[XB_XCNT(j)]); sum += c; cnt += (c > 0u) ? 1u : 0u; mine = (j == x) ? c : mine; }
        if (sum == G) break;
        __builtin_amdgcn_s_sleep(1);
        if ((++sp & 255u) == 0u) { if (xb_ld(&bar[XB_TMO])) break; if (sp > XB_SPIN_CAP) { atomicAdd(&bar[XB_TMO], 1u); break; } }
    }
    nloc = mine > 0u ? mine : 1u; nx = cnt > 0u ? cnt : 1u;
}
__device__ __forceinline__ void xcd_barrier(const XcdBarrier& b) {
    asm volatile("s_waitcnt vmcnt(0)" ::: "memory");
    __syncthreads();
    if (threadIdx.x == 0) {
        unsigned* bar = b.bar;
        __builtin_amdgcn_s_waitcnt(0);
        unsigned nloc = b.st[0], nx = b.st[1];
        if (nloc == 0u) { xcd_barrier_complete(bar, b.x, nloc, nx); b.st[0] = nloc; b.st[1] = nx; }
        const unsigned old = xb_add(&bar[XB_XSUB(b.x)], 1u);
        const unsigned gen = old / nloc;
        if (old + 1u == (gen + 1u) * nloc) {
            __builtin_amdgcn_fence(__ATOMIC_RELEASE, "agent");
            asm volatile("s_waitcnt vmcnt(0)" ::: "memory");
            const unsigned og = xb_add(&bar[XB_TOP], 1u);
            const unsigned tg = og / nx;
            if (og + 1u == (tg + 1u) * nx) xb_add(&bar[XB_TOPGEN], 1u);
            else XB_SPIN(xb_ld(&bar[XB_TOPGEN]) == tg, bar);
            __builtin_amdgcn_fence(__ATOMIC_ACQUIRE, "agent");
            xb_add(&bar[XB_XGEN(b.x)], 1u);
            asm volatile("s_waitcnt vmcnt(0)" ::: "memory");
        } else {
            XB_SPIN(xb_ld(&bar[XB_XGEN(b.x)]) == gen, bar);
            __builtin_amdgcn_fence(__ATOMIC_ACQUIRE, "agent");
            asm volatile("s_waitcnt vmcnt(0)" ::: "memory");
        }
    }
    __syncthreads();
}

namespace pg8 {
constexpr int BM = 256, BK = 64, HALF = 128, HTB = HALF * BK * 2, STAGE_BYTES = 8 * HTB, NXCD = 8, WGM = 8;
__host__ __device__ __forceinline__ int lds_byte(int r, int c) { const int st = (r >> 4) * 2 + (c >> 5), rr = r & 15, cc = c & 31, ob = rr * 64 + cc * 2; return st * 1024 + (ob ^ (((ob >> 9) & 1) << 5)); }
__host__ __device__ __forceinline__ void stage_rc(int b, int& R, int& C) { const int st = b / 1024, sb = b % 1024, swz = sb ^ (((sb >> 9) & 1) << 5); R = (st >> 1) * 16 + swz / 64; C = (st & 1) * 32 + (swz % 64) / 2; }
__host__ __device__ __forceinline__ int perm32(int rho) { const int n = rho >> 4, i = rho & 15; return 8 * (i >> 2) + 4 * n + (i & 3); }
struct Unit { int pm, pn; };
struct Prob {
    const char* A; const char* B; int nt, lda, ldb; size_t hstepB;
    size_t a_pm, a_pnhi; int a_sh;
    size_t b_pnlo, b_pnhi; int b_mask, b_sh;
    __device__ __forceinline__ const char* abase(const Unit& u) const { return A + (size_t)u.pm * a_pm + (size_t)(u.pn >> a_sh) * a_pnhi; }
    __device__ __forceinline__ const char* bbase(const Unit& u) const { return B + (size_t)(u.pn & b_mask) * b_pnlo + (size_t)(u.pn >> b_sh) * b_pnhi; }
};
__device__ __forceinline__ Prob plain_prob(const bf16_t* A, int lda, const bf16_t* Bt, int K) {
    Prob p; p.A = (const char*)A; p.B = (const char*)Bt; p.nt = K / BK; p.lda = lda; p.ldb = K; p.hstepB = (size_t)HALF * K * 2;
    p.a_pm = (size_t)BM * lda * 2; p.a_pnhi = 0; p.a_sh = 0; p.b_pnlo = (size_t)BM * K * 2; p.b_pnhi = 0; p.b_mask = ~0; p.b_sh = 0; return p;
}
struct StaticOrder {
    int nM, nN, nwg, G, c;
    __host__ __device__ void init(int nM_, int nN_, int G_, int c_) { nM = nM_; nN = nN_; nwg = nM * nN; G = G_; c = c_; }
    __host__ __device__ bool next(int i, Unit& u) const {
        const long L = (long)i * G + c; if (L >= nwg) return false;
        int wgid = (int)L; { const int q = nwg / NXCD, r = nwg % NXCD, xcd = wgid % NXCD, off = wgid / NXCD; wgid = (xcd < r ? xcd * (q + 1) : r * (q + 1) + (xcd - r) * q) + off; }
        const int nig = WGM * nN, gid = wgid / nig, fm = gid * WGM, gsz = (nM - fm) < WGM ? (nM - fm) : WGM;
        u.pm = fm + ((wgid % nig) % gsz); u.pn = (wgid % nig) / gsz; return true;
    }
    __device__ __forceinline__ void a_ready(const Unit&) const {}
    __device__ __forceinline__ void done(const Unit&) const {}
};
template <class Epi, class Prob, class Sched, bool ALIGN_EPI = false, bool SP2 = false>
__device__ __forceinline__ void gemm_phase(PG8_LAS unsigned char* lds, const Prob g, const Sched& S, const Epi& E) {
    int tid_raw = threadIdx.x; asm volatile("" : "+v"(tid_raw));
    const int tid = tid_raw, wid = __builtin_amdgcn_readfirstlane(tid >> 6), lane = tid & 63, wr = wid >> 2, wc = wid & 3, fr = lane & 15, fq = lane >> 4;
    const int nt = g.nt;
    unsigned voffA[2], voffB[2];
#pragma unroll
    for (int i = 0; i < 2; ++i) { int R, C; stage_rc(tid * 16 + i * 8192, R, C); const int Rb = Epi::brow(R);
        voffA[i] = (unsigned)(R * g.lda + C) * 2u; voffB[i] = (unsigned)(Rb * g.ldb + C) * 2u; }
    const size_t kstep = (size_t)(BK * 2);
    const size_t hstepA = (size_t)HALF * g.lda * 2, hstepB = g.hstepB;
    const unsigned ldsw = (unsigned)wid * 1024u;
    const int aoff = lds_byte(wr * 64 + fr, fq * 8), boff = lds_byte(wc * 32 + fr, fq * 8);
#define PG8_SA(b, h) (((b) * 2 + (h)) * HTB)
#define PG8_SB(b, h) ((4 + (b) * 2 + (h)) * HTB)
#define PG8_STAGE(bufoff, gbase, voff) do { _Pragma("unroll") for (int _i = 0; _i < 2; ++_i) \
        __builtin_amdgcn_global_load_lds((const unsigned*)((const char*)(gbase) + (voff)[_i]), (PG8_LAS unsigned*)(lds + (bufoff) + ldsw + _i * 8192), 16, 0, 0); } while (0)
#define PG8_LDA(dst, b, h) do { _Pragma("unroll") for (int m = 0; m < 4; ++m) _Pragma("unroll") for (int k = 0; k < 2; ++k) dst[m][k] = *(const PG8_LAS bf16x8*)(lds + PG8_SA(b, h) + aoff + m * 2048 + k * 1024); } while (0)
#define PG8_LDB(dst, b, h) do { _Pragma("unroll") for (int n = 0; n < 2; ++n) _Pragma("unroll") for (int k = 0; k < 2; ++k) dst[n][k] = *(const PG8_LAS bf16x8*)(lds + PG8_SB(b, h) + boff + n * 2048 + k * 1024); } while (0)
#define PG8_MMA(ai, bj, At, Bt) do { __builtin_amdgcn_s_setprio(1); _Pragma("unroll") for (int m = 0; m < 4; ++m) _Pragma("unroll") for (int n = 0; n < 2; ++n) _Pragma("unroll") for (int k = 0; k < 2; ++k) \
        acc[ai][bj][m][n] = __builtin_amdgcn_mfma_f32_16x16x32_bf16(Bt[n][k], At[m][k], acc[ai][bj][m][n], 0, 0, 0); __builtin_amdgcn_s_setprio(0); } while (0)
#define PG8_WAIT_V(n) asm volatile("s_waitcnt vmcnt(" #n ")" ::: "memory")
#define PG8_WAIT_L(n) asm volatile("s_waitcnt lgkmcnt(" #n ")" ::: "memory")
#define PG8_BAR __builtin_amdgcn_s_barrier()
#define PG8_SCHED __builtin_amdgcn_sched_barrier(0)
    Unit cur, nxt; int ui = 0;
    if (!S.next(0, cur)) return;
    f32x4 acc[2][2][4][2];
#pragma unroll
    for (int a = 0; a < 2; ++a)
#pragma unroll
        for (int b = 0; b < 2; ++b)
#pragma unroll
            for (int m = 0; m < 4; ++m)
#pragma unroll
                for (int n = 0; n < 2; ++n) acc[a][b][m][n] = (f32x4){0.f, 0.f, 0.f, 0.f};
    bf16x8 At[4][2], B0[2][2], B1[2][2];
    const char* cA = g.abase(cur); const char* cB = g.bbase(cur);
    S.a_ready(cur);
    if constexpr (SP2) {
        PG8_STAGE(PG8_SB(0, 0), cB, voffB); PG8_STAGE(PG8_SB(0, 1), cB + hstepB, voffB); PG8_STAGE(PG8_SA(0, 0), cA, voffA); PG8_STAGE(PG8_SA(0, 1), cA + hstepA, voffA);
        if (wr == 1) PG8_BAR;
        PG8_WAIT_V(2); PG8_BAR;
        PG8_STAGE(PG8_SB(1, 0), cB + kstep, voffB); PG8_STAGE(PG8_SA(1, 0), cA + kstep, voffA); PG8_STAGE(PG8_SB(1, 1), cB + hstepB + kstep, voffB);
        PG8_WAIT_V(6); PG8_BAR;
    } else {
        PG8_STAGE(PG8_SB(0, 0), cB, voffB); PG8_STAGE(PG8_SA(0, 0), cA, voffA); PG8_STAGE(PG8_SB(0, 1), cB + hstepB, voffB); PG8_STAGE(PG8_SA(0, 1), cA + hstepA, voffA);
        if (wr == 1) PG8_BAR;
        PG8_WAIT_V(4); PG8_BAR;
        PG8_STAGE(PG8_SB(1, 0), cB + kstep, voffB); PG8_STAGE(PG8_SA(1, 0), cA + kstep, voffA); PG8_STAGE(PG8_SB(1, 1), cB + hstepB + kstep, voffB);
        PG8_WAIT_V(6); PG8_BAR;
    }
    for (;;) {
        const bool has_next = S.next(ui + 1, nxt);
        const char* nA = has_next ? g.abase(nxt) : cA; const char* nB = has_next ? g.bbase(nxt) : cB;
        for (int t = 0; t < nt; t += 2) {
            const bool last = (t == nt - 2);
            const char* a1 = cA + (size_t)(t + 1) * kstep;
            const char* a2 = last ? nA : cA + (size_t)(t + 2) * kstep; const char* b2 = last ? nB : cB + (size_t)(t + 2) * kstep;
            const char* a3 = a2 + kstep; const char* b3 = b2 + kstep;
            if (last && has_next) S.a_ready(nxt);
            if constexpr (SP2) {
            PG8_LDB(B0, 0, 0); PG8_LDB(B1, 0, 1); PG8_SCHED; PG8_LDA(At, 0, 0); PG8_STAGE(PG8_SA(1, 1), a1 + hstepA, voffA);
            PG8_WAIT_V(8); PG8_WAIT_L(0); PG8_BAR; PG8_MMA(0, 0, At, B0); PG8_MMA(0, 1, At, B1); PG8_BAR; PG8_SCHED;
            PG8_LDA(At, 0, 1); PG8_STAGE(PG8_SB(0, 0), b2, voffB); PG8_STAGE(PG8_SB(0, 1), b2 + hstepB, voffB); PG8_STAGE(PG8_SA(0, 0), a2, voffA);
            PG8_WAIT_V(8); PG8_WAIT_L(0); PG8_BAR; PG8_MMA(1, 0, At, B0); PG8_MMA(1, 1, At, B1); PG8_BAR; PG8_SCHED;
            PG8_LDB(B0, 1, 0); PG8_LDB(B1, 1, 1); PG8_SCHED; PG8_LDA(At, 1, 0); PG8_STAGE(PG8_SA(0, 1), a2 + hstepA, voffA);
            PG8_WAIT_V(8); PG8_WAIT_L(0); PG8_BAR; PG8_MMA(0, 0, At, B0); PG8_MMA(0, 1, At, B1); PG8_BAR; PG8_SCHED;
            PG8_LDA(At, 1, 1); PG8_STAGE(PG8_SB(1, 0), b3, voffB); PG8_STAGE(PG8_SB(1, 1), b3 + hstepB, voffB); PG8_STAGE(PG8_SA(1, 0), a3, voffA);
            PG8_WAIT_V(8); PG8_WAIT_L(0); PG8_BAR; PG8_MMA(1, 0, At, B0); PG8_MMA(1, 1, At, B1); PG8_BAR; PG8_SCHED;
            } else {
            PG8_LDB(B0, 0, 0); PG8_SCHED; PG8_LDA(At, 0, 0); PG8_STAGE(PG8_SA(1, 1), a1 + hstepA, voffA);
            PG8_WAIT_L(8); PG8_BAR; PG8_WAIT_L(0); PG8_MMA(0, 0, At, B0); PG8_BAR; PG8_SCHED;
            PG8_LDB(B1, 0, 1); PG8_STAGE(PG8_SB(0, 0), b2, voffB);
            PG8_BAR; PG8_WAIT_L(0); PG8_MMA(0, 1, At, B1); PG8_BAR;
            PG8_LDA(At, 0, 1); PG8_STAGE(PG8_SA(0, 0), a2, voffA);
            PG8_BAR; PG8_WAIT_L(0); PG8_MMA(1, 0, At, B0); PG8_BAR; PG8_SCHED;
            PG8_STAGE(PG8_SB(0, 1), b2 + hstepB, voffB);
            PG8_WAIT_V(6); PG8_BAR; PG8_MMA(1, 1, At, B1); PG8_BAR;
            PG8_LDB(B0, 1, 0); PG8_SCHED; PG8_LDA(At, 1, 0); PG8_STAGE(PG8_SA(0, 1), a2 + hstepA, voffA);
            PG8_WAIT_L(8); PG8_BAR; PG8_WAIT_L(0); PG8_MMA(0, 0, At, B0); PG8_BAR; PG8_SCHED;
            PG8_LDB(B1, 1, 1); PG8_STAGE(PG8_SB(1, 0), b3, voffB);
            PG8_BAR; PG8_WAIT_L(0); PG8_MMA(0, 1, At, B1); PG8_BAR;
            PG8_LDA(At, 1, 1); PG8_STAGE(PG8_SA(1, 0), a3, voffA);
            PG8_BAR; PG8_WAIT_L(0); PG8_MMA(1, 0, At, B0); PG8_BAR; PG8_SCHED;
            PG8_STAGE(PG8_SB(1, 1), b3 + hstepB, voffB);
            PG8_WAIT_V(6); PG8_BAR; PG8_MMA(1, 1, At, B1); PG8_BAR;
            }
        }
        if constexpr (ALIGN_EPI) { if (wr == 0) PG8_BAR; }
        if constexpr (!Epi::AFTER_DRAIN) { E(acc, cur, wr, wc, fr, fq); S.done(cur); }
        if (!has_next) break;
#pragma unroll
        for (int a = 0; a < 2; ++a)
#pragma unroll
            for (int b = 0; b < 2; ++b)
#pragma unroll
                for (int m = 0; m < 4; ++m)
#pragma unroll
                    for (int n = 0; n < 2; ++n) acc[a][b][m][n] = (f32x4){0.f, 0.f, 0.f, 0.f};
        cur = nxt; cA = nA; cB = nB; ++ui;
        if constexpr (ALIGN_EPI) { if (wr == 1) PG8_BAR; }
    }
    PG8_WAIT_V(0);
    if constexpr (!ALIGN_EPI) { if (wr == 0) PG8_BAR; }
    PG8_BAR;
    if constexpr (Epi::AFTER_DRAIN) { E.fused(acc, cur, wr, wc, fr, fq, lds, wid, lane); S.done(cur); }
#undef PG8_SA
#undef PG8_SB
#undef PG8_STAGE
#undef PG8_LDA
#undef PG8_LDB
#undef PG8_MMA
#undef PG8_WAIT_V
#undef PG8_WAIT_L
#undef PG8_BAR
#undef PG8_SCHED
}

}
using pg8::Unit;

__device__ __forceinline__ int brow_perm(int R) { return (R & ~31) + pg8::perm32(R & 31); }

template <int XOR> __device__ __forceinline__ void rope8(float (&x)[8], const float* ct, const float* st, bool plus) {
    const f32x4 c0 = *(const f32x4*)ct, c1 = *(const f32x4*)(ct + 4), s0 = *(const f32x4*)st, s1 = *(const f32x4*)(st + 4);
    const float c[8] = {c0[0], c0[1], c0[2], c0[3], c1[0], c1[1], c1[2], c1[3]}, s[8] = {s0[0], s0[1], s0[2], s0[3], s1[0], s1[1], s1[2], s1[3]};
#pragma unroll
    for (int f = 0; f < 8; ++f) { const float p = __shfl_xor(x[f], XOR); x[f] = x[f] * c[f] + (plus ? p : -p) * s[f]; }
}

struct EpiP {
    static constexpr bool AFTER_DRAIN = false;
    static __device__ __forceinline__ int brow(int R) { return brow_perm(R); }
    bf16_t* P; float* ssq_q; float* ssq_kv;
    __device__ __forceinline__ void operator()(const f32x4 (&acc)[2][2][4][2], const Unit& u, int wr, int wc, int fr, int fq) const {
        asm volatile("" : "+v"(fr), "+v"(fq));
        const int pn = u.pn; const bool lat = u.pm < 64;
#pragma unroll
        for (int ai = 0; ai < 2; ++ai)
#pragma unroll
            for (int m = 0; m < 4; ++m) {
                const int row = u.pm * 256 + ai * 128 + wr * 64 + m * 16 + fr;
                const int grow = (u.pm * 4 + ai * 2 + wr) & 31, gcol = m * 16 + fr;
                float ss = 0.f;
#pragma unroll
                for (int bj = 0; bj < 2; ++bj) {
                    float x[8];
#pragma unroll
                    for (int n = 0; n < 2; ++n)
#pragma unroll
                        for (int e = 0; e < 4; ++e) x[4 * n + e] = acc[ai][bj][m][n][e];
                    int mode = 0; float sc = 1.f;
                    if (pn == 1) mode = (bj == 1 && wc == 0) ? 1 : 0;
                    else if (pn == 2) { mode = 1; sc = DIFF_SC; }
                    else if (pn == 3) mode = 1;
                    else if (pn == 5) { mode = 2; sc = WIN_SC; }
                    else if (pn == 6) mode = (bj == 0) ? 2 : 0;
                    else if (pn == 7) sc = NA_SC;
                    if (!lat) mode = 0;
                    if (pn == 0 || (pn == 1 && bj == 0)) {
#pragma unroll
                        for (int f = 0; f < 8; ++f) ss += x[f] * x[f];
                    }
                    if (mode == 1) { const int pos = (fq < 2) ? grow : gcol; rope8<16>(x, ROPE_COS32 + pos * 8, ROPE_SIN32 + pos * 8, (fq & 1) != 0); }
                    else if (mode == 2) { const int pos = (wc & 1) ? gcol : grow; rope8<32>(x, ROPE_COS64 + pos * 16 + (fq & 1) * 8, ROPE_SIN64 + pos * 16 + (fq & 1) * 8, fq >= 2); }
                    u32x4 w; w.x = cvt_pk_bf16(x[0] * sc, x[1] * sc); w.y = cvt_pk_bf16(x[2] * sc, x[3] * sc); w.z = cvt_pk_bf16(x[4] * sc, x[5] * sc); w.w = cvt_pk_bf16(x[6] * sc, x[7] * sc);
                    *(u32x4*)(P + (size_t)row * PW + pn * 256 + bj * 128 + wc * 32 + fq * 8) = w;
                }
                if (pn <= 1) {
                    ss += __shfl_xor(ss, 16); ss += __shfl_xor(ss, 32);
                    if (fq == 0) unsafeAtomicAdd((pn == 0 ? ssq_q : ssq_kv) + row, ss);
                }
            }
    }
};

struct EpiUp {
    static constexpr bool AFTER_DRAIN = false;
    static __device__ __forceinline__ int brow(int R) { return brow_perm(R); }
    bf16_t* Q; const float* ssq_q; const float* ssq_kv;
    __device__ __forceinline__ void operator()(const f32x4 (&acc)[2][2][4][2], const Unit& u, int wr, int wc, int fr, int fq) const {
        asm volatile("" : "+v"(fr), "+v"(fq));
        const int pn = u.pn; const bool lat = u.pm < 64;
#pragma unroll
        for (int ai = 0; ai < 2; ++ai)
#pragma unroll
            for (int m = 0; m < 4; ++m) {
                const int row = u.pm * 256 + ai * 128 + wr * 64 + m * 16 + fr;
                const int grow = (u.pm * 4 + ai * 2 + wr) & 31, gcol = m * 16 + fr;
                const float rq = __builtin_amdgcn_rsqf(__hip_atomic_load(ssq_q + row, __ATOMIC_RELAXED, __HIP_MEMORY_SCOPE_AGENT) * (1.f / 256.f) + EPS) * MLA_SC;
                const float rkv = __builtin_amdgcn_rsqf(__hip_atomic_load(ssq_kv + row, __ATOMIC_RELAXED, __HIP_MEMORY_SCOPE_AGENT) * (1.f / 128.f) + EPS);
#pragma unroll
                for (int bj = 0; bj < 2; ++bj) {
                    const int g32 = pn * 8 + bj * 4 + wc;
                    float x[8];
#pragma unroll
                    for (int n = 0; n < 2; ++n)
#pragma unroll
                        for (int e = 0; e < 4; ++e) x[4 * n + e] = acc[ai][bj][m][n][e];
                    const float sc = g32 < 12 ? rq : (g32 < 28 ? rkv : 0.f);
                    if (g32 < 12 && (g32 % 3) == 2 && lat) { const int pos = (fq < 2) ? grow : gcol; rope8<16>(x, ROPE_COS32 + pos * 8, ROPE_SIN32 + pos * 8, (fq & 1) != 0); }
                    u32x4 w; w.x = cvt_pk_bf16(x[0] * sc, x[1] * sc); w.y = cvt_pk_bf16(x[2] * sc, x[3] * sc); w.z = cvt_pk_bf16(x[4] * sc, x[5] * sc); w.w = cvt_pk_bf16(x[6] * sc, x[7] * sc);
                    *(u32x4*)(Q + (size_t)row * QW + pn * 256 + bj * 128 + wc * 32 + fq * 8) = w;
                }
            }
    }
};

template <int ACT> struct EpiBf16 {
    static constexpr bool AFTER_DRAIN = false;
    static __device__ __forceinline__ int brow(int R) { return brow_perm(R); }
    bf16_t* O; int ldc;
    __device__ __forceinline__ void operator()(const f32x4 (&acc)[2][2][4][2], const Unit& u, int wr, int wc, int fr, int fq) const {
        asm volatile("" : "+v"(fr), "+v"(fq));
#pragma unroll
        for (int ai = 0; ai < 2; ++ai)
#pragma unroll
            for (int m = 0; m < 4; ++m) {
                bf16_t* rowp = O + (size_t)(u.pm * 256 + ai * 128 + wr * 64 + m * 16 + fr) * ldc + u.pn * 256 + wc * 32 + fq * 8;
#pragma unroll
                for (int bj = 0; bj < 2; ++bj) {
                    f32x4 v0 = acc[ai][bj][m][0], v1 = acc[ai][bj][m][1];
                    if (ACT == 1) {
#pragma unroll
                        for (int e = 0; e < 4; ++e) { const float a = fmaxf(v0[e], 0.f), b = fmaxf(v1[e], 0.f); v0[e] = a * a; v1[e] = b * b; }
                    }
                    u32x4 w; w.x = cvt_pk_bf16(v0[0], v0[1]); w.y = cvt_pk_bf16(v0[2], v0[3]); w.z = cvt_pk_bf16(v1[0], v1[1]); w.w = cvt_pk_bf16(v1[2], v1[3]);
                    *(u32x4*)(rowp + bj * 128) = w;
                }
            }
    }
};

struct EpiMerge {
    static constexpr bool AFTER_DRAIN = false;
    static __device__ __forceinline__ int brow(int R) { return ((R >> 4) & 1) * 1024 + 16 * (R >> 5) + (R & 15); }
    bf16_t* Y; const bf16_t* Bcat; const float* bg;
    __device__ __forceinline__ void operator()(const f32x4 (&acc)[2][2][4][2], const Unit& u, int wr, int wc, int fr, int fq) const {
        asm volatile("" : "+v"(fr), "+v"(fq));
        const int col = u.pn * 64 + wc * 16 + fq * 4;
        f32x4 bv[2][2];
#pragma unroll
        for (int bj = 0; bj < 2; ++bj)
#pragma unroll
            for (int n = 0; n < 2; ++n) bv[bj][n] = *(const f32x4*)(bg + (2 * bj + n) * 1024 + col);
#pragma unroll
        for (int ai = 0; ai < 2; ++ai)
#pragma unroll
            for (int m = 0; m < 4; ++m) {
                const int row = u.pm * 256 + ai * 128 + wr * 64 + m * 16 + fr;
                f32x4 y = {0.f, 0.f, 0.f, 0.f};
#pragma unroll
                for (int bj = 0; bj < 2; ++bj)
#pragma unroll
                    for (int n = 0; n < 2; ++n) {
                        const u32x2 bw = *(const u32x2*)(Bcat + (size_t)row * 4096 + (2 * bj + n) * 1024 + col);
                        const float b[4] = {bf_lo(bw.x), bf_hi(bw.x), bf_lo(bw.y), bf_hi(bw.y)};
#pragma unroll
                        for (int e = 0; e < 4; ++e) {
                            const float g = acc[ai][bj][m][n][e] + bv[bj][n][e];
                            const float sg = __builtin_amdgcn_rcpf(1.f + fast_exp2(-g * LOG2E));
                            y[e] += sg * b[e];
                        }
                    }
                u32x2 w; w.x = cvt_pk_bf16(y[0], y[1]); w.y = cvt_pk_bf16(y[2], y[3]);
                *(u32x2*)(Y + (size_t)row * DM + col) = w;
            }
    }
};

struct EpiRes {
    static constexpr bool AFTER_DRAIN = false;
    static __device__ __forceinline__ int brow(int R) { return R; }
    const float* old_lat; const float* old_ctx; float* new_lat; float* new_ctx; const float* modv;
    __device__ __forceinline__ void operator()(const f32x4 (&acc)[2][2][4][2], const Unit& u, int wr, int wc, int fr, int fq) const {
        asm volatile("" : "+v"(fr), "+v"(fq));
        const bool lat = u.pm < 64; const int r = lat ? (u.pm >> 3) : 8;
        const float* ob = lat ? old_lat : old_ctx - (size_t)NLAT * DM; float* nb = lat ? new_lat : new_ctx - (size_t)NLAT * DM;
        const int col0 = u.pn * 256 + wc * 32 + fq * 4;
        f32x4 gv[2][2];
#pragma unroll
        for (int bj = 0; bj < 2; ++bj)
#pragma unroll
            for (int n = 0; n < 2; ++n) gv[bj][n] = *(const f32x4*)(modv + (size_t)r * 6144 + col0 + bj * 128 + n * 16);
#pragma unroll
        for (int ai = 0; ai < 2; ++ai)
#pragma unroll
            for (int m = 0; m < 4; ++m) {
                const size_t off = (size_t)(u.pm * 256 + ai * 128 + wr * 64 + m * 16 + fr) * DM + col0;
#pragma unroll
                for (int bj = 0; bj < 2; ++bj)
#pragma unroll
                    for (int n = 0; n < 2; ++n) { const f32x4 o = *(const f32x4*)(ob + off + bj * 128 + n * 16); *(f32x4*)(nb + off + bj * 128 + n * 16) = o + gv[bj][n] * acc[ai][bj][m][n]; }
            }
    }
};

struct Args { const float* in[24]; float* out; unsigned char* ws; int ph_lo, ph_hi; };

struct Frame {
    LAS unsigned char* lds;
    int wave, G, vcu;
    Args a;
};

__device__ __forceinline__ void tr_item(const float* W, int ldw, int ks0, int cs0, bool valid, const float* gain, bf16_t* WT, int ldt, int n0, int k0, LAS float* scr, int lane) {
#pragma unroll 8
    for (int i = 0; i < 32; ++i) {
        const int kk = 2 * i + (lane >> 5), j = lane & 31; float v = 0.f;
        if (valid) { v = W[(size_t)(ks0 + kk) * ldw + cs0 + j]; if (gain) v *= gain[ks0 + kk]; }
        scr[kk * 33 + j] = v;
    }
    LDS_WAIT(); asm volatile("" ::: "memory");
    const int c = lane & 7;
#pragma unroll
    for (int j = 0; j < 4; ++j) { const int n = (lane >> 3) + 8 * j; const LAS float* s = scr + (8 * c) * 33 + n;
        u32x4 o; o.x = cvt_pk_bf16(s[0 * 33], s[1 * 33]); o.y = cvt_pk_bf16(s[2 * 33], s[3 * 33]); o.z = cvt_pk_bf16(s[4 * 33], s[5 * 33]); o.w = cvt_pk_bf16(s[6 * 33], s[7 * 33]);
        *(u32x4*)(WT + (size_t)(n0 + n) * ldt + k0 + 8 * c) = o; }
    LDS_WAIT(); asm volatile("" ::: "memory");
}
__device__ __forceinline__ void convert_weights(Frame& F, int l) {
    int lane_ = threadIdx.x; asm volatile("" : "+v"(lane_)); lane_ &= 63;
    LAS float* scr = (LAS float*)(F.lds + F.wave * 16384);
    const int gw = F.vcu * NWAVES + F.wave, NGW = F.G * NWAVES;
    constexpr int I_IN = 16 * 80, I_UP = 6 * 32, I_G = 16 * 128, I_B = 16 * 32, I_O = 16 * 32, I_1 = 16 * 128, I_2 = 64 * 32;
    constexpr int NIT = I_IN + I_UP + I_G + I_B + I_O + I_1 + I_2;
    unsigned char* ws = F.a.ws;
    for (int it = gw; it < NIT; it += NGW) {
        int r = it;
        if (r < I_IN) { const int kb = r / 80, nb = r % 80, n0 = nb * 32; const bool valid = !(n0 >= 416 && n0 < 512); const int cs0 = n0 < 416 ? n0 : n0 - 96;
            tr_item(F.a.in[I_WIN] + (size_t)l * DM * INW, INW, kb * 64, cs0, valid, nullptr, (bf16_t*)(ws + WS_WIN), DM, n0, kb * 64, scr, lane_); continue; } r -= I_IN;
        if (r < I_UP) { const int kb = r / 32, nb = r % 32, n0 = nb * 32, k0 = kb * 64;
            if (kb < 4) tr_item(F.a.in[I_WUQ] + (size_t)l * 256 * 384, 384, k0, n0, n0 < 384, F.a.in[I_QNORM] + l * 256, (bf16_t*)(ws + WS_WUP), 384, n0, k0, scr, lane_);
            else tr_item(F.a.in[I_WUKV] + (size_t)l * 128 * 512, 512, k0 - 256, n0 - 384, n0 >= 384 && n0 < 896, F.a.in[I_KVNORM] + l * 128, (bf16_t*)(ws + WS_WUP), 384, n0, k0, scr, lane_);
            continue; } r -= I_UP;
        if (r < I_G) { const int kb = r / 128, nb = r % 128; tr_item(F.a.in[I_WGATE] + (size_t)l * DM * 4096, 4096, kb * 64, nb * 32, true, nullptr, (bf16_t*)(ws + WS_WGATE), DM, nb * 32, kb * 64, scr, lane_); continue; } r -= I_G;
        if (r < I_B) { const int kb = r / 32, nb = r % 32; tr_item(F.a.in[I_WBR] + (size_t)l * DM * DM, DM, kb * 64, nb * 32, true, nullptr, (bf16_t*)(ws + WS_WBR), DM, nb * 32, kb * 64, scr, lane_); continue; } r -= I_B;
        if (r < I_O) { const int kb = r / 32, nb = r % 32; tr_item(F.a.in[I_WOUT] + (size_t)l * DM * DM, DM, kb * 64, nb * 32, true, nullptr, (bf16_t*)(ws + WS_WOUT), DM, nb * 32, kb * 64, scr, lane_); continue; } r -= I_O;
        if (r < I_1) { const int kb = r / 128, nb = r % 128; tr_item(F.a.in[I_FF1] + (size_t)l * DM * FF, FF, kb * 64, nb * 32, true, nullptr, (bf16_t*)(ws + WS_WFF1), DM, nb * 32, kb * 64, scr, lane_); continue; } r -= I_1;
        { const int kb = r / 32, nb = r % 32; tr_item(F.a.in[I_FF2] + (size_t)l * FF * DM, DM, kb * 64, nb * 32, true, nullptr, (bf16_t*)(ws + WS_WFF2), FF, nb * 32, kb * 64, scr, lane_); }
    }
}

__device__ __forceinline__ void mod_vectors(Frame& F) {
    const int t = blockIdx.x; if (t >= 192) return;
    int tid_ = threadIdx.x; asm volatile("" : "+v"(tid_)); int lane_ = tid_ & 63; asm volatile("" : "+v"(lane_), "+v"(tid_));
    const int l = t / 96, col = (t % 96) * 64 + lane_;
    LAS float* sv = (LAS float*)F.lds;
    LAS float* red = (LAS float*)(F.lds + 9 * 1024 * 4);
    for (int i = tid_; i < 9 * 1024; i += 512) { const int r = i >> 10, k = i & 1023; const float x = r < 8 ? F.a.in[I_C][r * 1024 + k] : F.a.in[I_CCTX][k]; sv[i] = x / (1.f + __expf(-x)); }
    __syncthreads();
    float a[9];
#pragma unroll
    for (int r = 0; r < 9; ++r) a[r] = 0.f;
    const float* w = F.a.in[I_WADA] + (size_t)l * DM * 6144 + col;
    const int kbeg = F.wave * 128;
#pragma unroll 4
    for (int k = kbeg; k < kbeg + 128; ++k) { const float wv = w[(size_t)k * 6144];
#pragma unroll
        for (int r = 0; r < 9; ++r) a[r] += sv[r * 1024 + k] * wv; }
#pragma unroll
    for (int r = 0; r < 9; ++r) red[(F.wave * 9 + r) * 64 + lane_] = a[r];
    __syncthreads();
    if (F.wave == 0) {
        const float bb = F.a.in[I_BADA][l * 6144 + col];
        float* mod = (float*)(F.a.ws + WS_MOD) + (size_t)l * 9 * 6144;
#pragma unroll
        for (int r = 0; r < 9; ++r) { float s = bb;
#pragma unroll
            for (int wv = 0; wv < 8; ++wv) s += red[(wv * 9 + r) * 64 + lane_];
            mod[r * 6144 + col] = s; }
    }
    __syncthreads();
}

__device__ __forceinline__ void adaln_rows(Frame& F, const float* xlat, const float* xctx, int nrows, const float* g, const float* modl, int c_shift, int c_scale, bf16_t* H) {
    const int gw = F.vcu * NWAVES + F.wave, NGW = F.G * NWAVES;
    int lane_ = threadIdx.x; asm volatile("" : "+v"(lane_)); lane_ &= 63;
    for (int row = gw; row < nrows; row += NGW) {
        const float* xr = row < NLAT ? xlat + (size_t)row * DM : xctx + (size_t)(row - NLAT) * DM;
        const int r = row < NLAT ? (row >> 11) : 8;
        const float* sh = modl + (size_t)r * 6144 + c_shift * 1024; const float* sc = modl + (size_t)r * 6144 + c_scale * 1024;
        f32x4 v[4]; float s = 0.f;
#pragma unroll
        for (int j = 0; j < 4; ++j) { v[j] = *(const f32x4*)(xr + 256 * j + 4 * lane_); s += (v[j][0] * v[j][0] + v[j][1] * v[j][1]) + (v[j][2] * v[j][2] + v[j][3] * v[j][3]); }
        const float rstd = 1.f / sqrtf(wave_sum(s) * (1.f / DM) + EPS);
#pragma unroll
        for (int j = 0; j < 4; ++j) {
            const int c = 256 * j + 4 * lane_;
            const f32x4 gg = *(const f32x4*)(g + c), s1 = *(const f32x4*)(sc + c), s0 = *(const f32x4*)(sh + c);
            f32x4 o;
#pragma unroll
            for (int e = 0; e < 4; ++e) o[e] = (v[j][e] * rstd * gg[e]) * (1.f + s1[e]) + s0[e];
            u32x2 w; w.x = cvt_pk_bf16(o[0], o[1]); w.y = cvt_pk_bf16(o[2], o[3]);
            *(u32x2*)(H + (size_t)row * DM + c) = w;
        }
    }
}
__device__ __forceinline__ void final_norm(Frame& F) {
    const int gw = F.vcu * NWAVES + F.wave, NGW = F.G * NWAVES;
    const float* g = F.a.in[I_FNORM];
    int lane_ = threadIdx.x; asm volatile("" : "+v"(lane_)); lane_ &= 63;
    for (int row = gw; row < NLAT; row += NGW) {
        float* xr = F.a.out + (size_t)row * DM;
        f32x4 v[4]; float s = 0.f;
#pragma unroll
        for (int j = 0; j < 4; ++j) { v[j] = *(const f32x4*)(xr + 256 * j + 4 * lane_); s += (v[j][0] * v[j][0] + v[j][1] * v[j][1]) + (v[j][2] * v[j][2] + v[j][3] * v[j][3]); }
        const float rstd = 1.f / sqrtf(wave_sum(s) * (1.f / DM) + EPS);
#pragma unroll
        for (int j = 0; j < 4; ++j) { const int c = 256 * j + 4 * lane_; const f32x4 gg = *(const f32x4*)(g + c); *(f32x4*)(xr + c) = v[j] * rstd * gg; }
    }
}

typedef float f32x16 __attribute__((ext_vector_type(16)));
typedef short s16x4 __attribute__((ext_vector_type(4)));
typedef short v4i16_t __attribute__((ext_vector_type(4)));
__device__ __forceinline__ int crow(int r, int hi) { return (r & 3) + 8 * (r >> 2) + 4 * hi; }
__device__ __forceinline__ s16x4 vtr(const LAS unsigned char* p) { return __builtin_bit_cast(s16x4, __builtin_amdgcn_ds_read_tr16_b64_v4i16((LAS v4i16_t*)p)); }
constexpr int AT_KVBUF = 21504, AT_KBYTES = 13312, AT_RPB = 2 * AT_KVBUF;
struct SetState { float m, l; f32x16 o0, o1; };
__device__ __forceinline__ void set_init(SetState& s) { s.m = -1e30f; s.l = 0.f;
#pragma unroll
    for (int r = 0; r < 16; ++r) { s.o0[r] = 0.f; s.o1[r] = 0.f; } }
struct StageRegs { u32x4 k1, k2, v; };
template <bool K2> __device__ __forceinline__ void stage_load(StageRegs& R, const bf16_t* k1, int p1, const bf16_t* k2, int p2, const bf16_t* v, int pv, int tid) {
    const int key = tid >> 3, ch = tid & 7;
    R.k1 = *(const u32x4*)(k1 + (size_t)key * p1 + ch * 8);
    R.v = *(const u32x4*)(v + (size_t)key * pv + ch * 8);
    if (K2) { if (tid < 256) R.k2 = *(const u32x4*)(k2 + (size_t)(tid >> 2) * p2 + (tid & 3) * 8); }
}
template <bool K2, int KSTRIDE> __device__ __forceinline__ void stage_write(LAS unsigned char* buf, const StageRegs& R, int tid) {
    const int key = tid >> 3, ch = tid & 7;
    *(LAS u32x4*)(buf + key * KSTRIDE + ch * 16) = R.k1;
    *(LAS u32x4*)(buf + AT_KBYTES + (ch >> 2) * 4096 + key * 64 + (ch & 3) * 16) = R.v;
    if (K2) { if (tid < 256) *(LAS u32x4*)(buf + (tid >> 2) * KSTRIDE + 128 + (tid & 3) * 16) = R.k2; }
}
template <int NST> __device__ __forceinline__ f32x16 qk32(const LAS unsigned char* krow, const bf16x8* qf) {
    f32x16 acc;
#pragma unroll
    for (int r = 0; r < 16; ++r) acc[r] = 0.f;
#pragma unroll
    for (int s = 0; s < NST; ++s) { const bf16x8 kf = *(const LAS bf16x8*)(krow + s * 32); acc = __builtin_amdgcn_mfma_f32_32x32x16_bf16(kf, qf[s], acc, 0, 0, 0); }
    return acc;
}
template <int NSUB> __device__ __forceinline__ void softmax_pack(SetState& st, f32x16 (&p)[NSUB], bf16x8 (&pf)[NSUB][2]) {
    float mx = p[0][0];
#pragma unroll
    for (int sub = 0; sub < NSUB; ++sub)
#pragma unroll
        for (int r = 0; r < 16; ++r) mx = fmaxf(mx, p[sub][r]);
    mx = fmaxf(mx, __shfl_xor(mx, 32));
    const float mn = fmaxf(st.m, mx), alpha = fast_exp2(st.m - mn); st.m = mn;
    float sum = 0.f;
#pragma unroll
    for (int sub = 0; sub < NSUB; ++sub)
#pragma unroll
        for (int r = 0; r < 16; ++r) { p[sub][r] = fast_exp2(p[sub][r] - mn); sum += p[sub][r]; }
    st.l = st.l * alpha + sum;
    if (__any(alpha != 1.f)) { st.o0 *= alpha; st.o1 *= alpha; }
#pragma unroll
    for (int sub = 0; sub < NSUB; ++sub)
#pragma unroll
        for (int s = 0; s < 2; ++s) { u32x4 w; w.x = cvt_pk_bf16(p[sub][8 * s + 0], p[sub][8 * s + 1]); w.y = cvt_pk_bf16(p[sub][8 * s + 2], p[sub][8 * s + 3]);
            w.z = cvt_pk_bf16(p[sub][8 * s + 4], p[sub][8 * s + 5]); w.w = cvt_pk_bf16(p[sub][8 * s + 6], p[sub][8 * s + 7]); pf[sub][s] = __builtin_bit_cast(bf16x8, w); }
}
template <int NSETS, int NSUB> __device__ __forceinline__ void pv_step(SetState (&st)[NSETS], const bf16x8 (&pf)[NSETS][NSUB][2], const LAS unsigned char* vlane, const int (&subrow)[NSUB]) {
#pragma unroll
    for (int sub = 0; sub < NSUB; ++sub)
#pragma unroll
        for (int s = 0; s < 2; ++s) {
            const LAS unsigned char* vp = vlane + (subrow[sub] + 16 * s) * 64;
            const s16x4 l0 = vtr(vp), h0 = vtr(vp + 512), l1 = vtr(vp + 4096), h1 = vtr(vp + 4096 + 512);
            const bf16x8 v0 = {l0[0], l0[1], l0[2], l0[3], h0[0], h0[1], h0[2], h0[3]}, v1 = {l1[0], l1[1], l1[2], l1[3], h1[0], h1[1], h1[2], h1[3]};
#pragma unroll
            for (int z = 0; z < NSETS; ++z) { st[z].o0 = __builtin_amdgcn_mfma_f32_32x32x16_bf16(v0, pf[z][sub][s], st[z].o0, 0, 0, 0); st[z].o1 = __builtin_amdgcn_mfma_f32_32x32x16_bf16(v1, pf[z][sub][s], st[z].o1, 0, 0, 0); }
        }
}
__device__ __forceinline__ void store_o(bf16_t* orow, const f32x16& o0, const f32x16& o1, int hi) {
#pragma unroll
    for (int g = 0; g < 4; ++g) {
        u32x2 w; w.x = cvt_pk_bf16(o0[4 * g], o0[4 * g + 1]); w.y = cvt_pk_bf16(o0[4 * g + 2], o0[4 * g + 3]); *(u32x2*)(orow + 8 * g + 4 * hi) = w;
        w.x = cvt_pk_bf16(o1[4 * g], o1[4 * g + 1]); w.y = cvt_pk_bf16(o1[4 * g + 2], o1[4 * g + 3]); *(u32x2*)(orow + 32 + 8 * g + 4 * hi) = w;
    }
}
template <int N> __device__ __forceinline__ void load_qf(bf16x8 (&qf)[N], const bf16_t* q, int hi) {
#pragma unroll
    for (int s = 0; s < N; ++s) qf[s] = *(const bf16x8*)(q + 16 * s + 8 * hi);
}
template <bool K2, int KSTRIDE, class LoadF, class CompF> __device__ __forceinline__ void tile_pipeline(int nt, LAS unsigned char* lds, int tid, LoadF load, CompF comp) {
    StageRegs R; load(0, R); stage_write<K2, KSTRIDE>(lds, R, tid); __syncthreads();
    for (int t = 0; t < nt; ++t) {
        if (t + 1 < nt) load(t + 1, R);
        comp(lds + (t & 1) * AT_KVBUF, t);
        if (t + 1 < nt) stage_write<K2, KSTRIDE>(lds + ((t + 1) & 1) * AT_KVBUF, R, tid);
        __syncthreads();
    }
}

struct AttnBufs { const bf16_t* P; const bf16_t* Q; bf16_t* O; const float* dlam; const float* subln; const float* sink; const float* rpb; float lam_init; bool need_ctx; };
struct AttnLane { int tid, lane, q31, hi, wave, voff; };
__device__ __forceinline__ AttnLane make_lane() {
    AttnLane A; A.tid = threadIdx.x; asm volatile("" : "+v"(A.tid)); A.lane = A.tid & 63; A.q31 = A.lane & 31; A.hi = A.lane >> 5; A.wave = __builtin_amdgcn_readfirstlane(A.tid >> 6);
    A.voff = ((A.lane >> 4) & 1) * 32 + (A.lane & 3) * 8 + (4 * A.hi + ((A.lane & 15) >> 2)) * 64; return A;
}

__device__ __forceinline__ void attn_mla(const AttnBufs& T, LAS unsigned char* lds, int b, int h, int qblk, bool ctxq) {
    const AttnLane A = make_lane();
    const int row = (ctxq ? NLAT + b * CTXL : b * SEQ + qblk * 256) + A.wave * 32 + A.q31;
    bf16x8 qf[6]; load_qf<6>(qf, T.Q + (size_t)row * QW + 96 * h, A.hi);
    SetState st[1]; set_init(st[0]);
    const int nt = ctxq ? 4 : 36;
    tile_pipeline<true, 208>(nt, lds, A.tid,
        [&](int t, StageRegs& R) { const int rb = t < 4 ? NLAT + b * CTXL + 64 * t : b * SEQ + 64 * (t - 4);
            stage_load<true>(R, T.Q + (size_t)rb * QW + UC_KV + 128 * h, QW, T.P + (size_t)rb * PW + PC_KR, PW, T.Q + (size_t)rb * QW + UC_KV + 128 * h + 64, QW, A.tid); },
        [&](LAS unsigned char* buf, int) {
            f32x16 p[2]; bf16x8 pf[1][2][2]; const int subrow[2] = {0, 32};
            p[0] = qk32<6>(buf + A.q31 * 208 + A.hi * 16, qf); p[1] = qk32<6>(buf + (32 + A.q31) * 208 + A.hi * 16, qf);
            softmax_pack<2>(st[0], p, pf[0]);
            pv_step<1, 2>(st, pf, buf + AT_KBYTES + A.voff, subrow); });
    float l = st[0].l; l += __shfl_xor(l, 32); const float il = 1.f / l;
    st[0].o0 *= il; st[0].o1 *= il;
    store_o(T.O + (size_t)row * DM + 0 + 64 * h, st[0].o0, st[0].o1, A.hi);
}
__device__ __forceinline__ void attn_diff(const AttnBufs& T, LAS unsigned char* lds, int b, int h, int qblk, bool ctxq) {
    const AttnLane A = make_lane();
    const int row = (ctxq ? NLAT + b * CTXL : b * SEQ + qblk * 256) + A.wave * 32 + A.q31;
    bf16x8 q1[2], q2[2]; load_qf<2>(q1, T.P + (size_t)row * PW + PC_DQ + 64 * h, A.hi); load_qf<2>(q2, T.P + (size_t)row * PW + PC_DQ + 64 * h + 32, A.hi);
    SetState st[2]; set_init(st[0]); set_init(st[1]);
    const int nt = ctxq ? 4 : 36;
    tile_pipeline<false, 144>(nt, lds, A.tid,
        [&](int t, StageRegs& R) { const int rb = t < 4 ? NLAT + b * CTXL + 64 * t : b * SEQ + 64 * (t - 4);
            stage_load<false>(R, T.P + (size_t)rb * PW + PC_DK + 64 * h, PW, nullptr, 0, T.P + (size_t)rb * PW + PC_DV + 64 * h, PW, A.tid); },
        [&](LAS unsigned char* buf, int) {
            f32x16 p[2]; bf16x8 pf[2][2][2]; const int subrow[2] = {0, 32};
            p[0] = qk32<2>(buf + A.q31 * 144 + A.hi * 16, q1); p[1] = qk32<2>(buf + (32 + A.q31) * 144 + A.hi * 16, q1);
            softmax_pack<2>(st[0], p, pf[0]);
            p[0] = qk32<2>(buf + A.q31 * 144 + A.hi * 16 + 64, q2); p[1] = qk32<2>(buf + (32 + A.q31) * 144 + A.hi * 16 + 64, q2);
            softmax_pack<2>(st[1], p, pf[1]);
            pv_step<2, 2>(st, pf, buf + AT_KBYTES + A.voff, subrow); });
    float a0 = 0.f, a1 = 0.f;
#pragma unroll
    for (int i = 0; i < 32; ++i) { a0 += T.dlam[i] * T.dlam[32 + i]; a1 += T.dlam[64 + i] * T.dlam[96 + i]; }
    const float lam = __expf(a0) - __expf(a1) + T.lam_init;
    float l1 = st[0].l, l2 = st[1].l; l1 += __shfl_xor(l1, 32); l2 += __shfl_xor(l2, 32);
    const float i1 = 1.f / l1, i2 = lam / l2;
    f32x16 o0 = st[0].o0 * i1 - st[1].o0 * i2, o1 = st[0].o1 * i1 - st[1].o1 * i2;
    float ss = 0.f;
#pragma unroll
    for (int r = 0; r < 16; ++r) ss += o0[r] * o0[r] + o1[r] * o1[r];
    ss += __shfl_xor(ss, 32);
    const float rs = (1.f / sqrtf(ss * (1.f / 64.f) + EPS)) * (1.f - T.lam_init);
#pragma unroll
    for (int r = 0; r < 16; ++r) { o0[r] *= rs * T.subln[crow(r, A.hi)]; o1[r] *= rs * T.subln[32 + crow(r, A.hi)]; }
    store_o(T.O + (size_t)row * DM + 256 + 64 * h, o0, o1, A.hi);
}
__device__ __forceinline__ void attn_win(const AttnBufs& T, LAS unsigned char* lds, int b, int kvh, int n, bool ctxq) {
    const AttnLane A = make_lane();
    const int hq = 2 * kvh + (A.wave >> 2);
    const int qpos = n * 128 + (A.wave & 3) * 32 + A.q31;
    const int row = (ctxq ? NLAT + b * CTXL : b * SEQ) + qpos;
    bf16x8 qf[4]; load_qf<4>(qf, T.P + (size_t)row * PW + PC_WQ + 64 * hq, A.hi);
    SetState st[1]; set_init(st[0]);
    const int lt0 = (n == 0) ? 2 : 0, lt1 = (n == 15) ? 3 : 5;
    const int nt = ctxq ? 4 : 4 + (lt1 - lt0 + 1);
    const int q0 = n * 128 + (A.wave & 3) * 32;
    tile_pipeline<false, 144>(nt, lds, A.tid,
        [&](int t, StageRegs& R) { const int rb = t < 4 ? NLAT + b * CTXL + 64 * t : b * SEQ + n * 128 - 128 + 64 * (lt0 + t - 4);
            stage_load<false>(R, T.P + (size_t)rb * PW + PC_WK + 64 * kvh, PW, nullptr, 0, T.P + (size_t)rb * PW + PC_WV + 64 * kvh, PW, A.tid); },
        [&](LAS unsigned char* buf, int t) {
            const int kp0 = n * 128 - 128 + 64 * (lt0 + t - 4);
            if (t >= 4 && (kp0 > q0 + 31 + 128 || kp0 + 63 < q0 - 128)) return;
            f32x16 p[2]; bf16x8 pf[1][2][2]; const int subrow[2] = {0, 32};
            p[0] = qk32<4>(buf + A.q31 * 144 + A.hi * 16, qf); p[1] = qk32<4>(buf + (32 + A.q31) * 144 + A.hi * 16, qf);
            if (t >= 4) {
#pragma unroll
                for (int sub = 0; sub < 2; ++sub)
#pragma unroll
                    for (int r = 0; r < 16; ++r) { const int d = qpos - (kp0 + 32 * sub + crow(r, A.hi)); if (d > 128 || d < -128) p[sub][r] = -1e30f; }
            }
            softmax_pack<2>(st[0], p, pf[0]);
            pv_step<1, 2>(st, pf, buf + AT_KBYTES + A.voff, subrow); });
    float l = st[0].l; l += __shfl_xor(l, 32); l += fast_exp2(T.sink[hq] * LOG2E - st[0].m);
    const float il = 1.f / l; st[0].o0 *= il; st[0].o1 *= il;
    store_o(T.O + (size_t)row * DM + 512 + 64 * hq, st[0].o0, st[0].o1, A.hi);
}
__device__ __forceinline__ int na_rs(int r) { int s = r - 4; return s < 0 ? 0 : (s > 24 ? 24 : s); }
__device__ __forceinline__ void attn_na(const AttnBufs& T, LAS unsigned char* lds, int b, int h, int rq) {
    const AttnLane A = make_lane();
    const int R0 = 4 * rq, qr0 = R0 + 2 * (A.wave >> 2), cb = A.wave & 3;
    const int qrow = qr0 + (A.q31 >> 4), qcol = 16 * cb + (A.q31 & 15);
    const int row = b * SEQ + 64 * qrow + qcol;
    bf16x8 qf[4]; load_qf<4>(qf, T.P + (size_t)row * PW + PC_NQ + 64 * h, A.hi);
    LAS float* bias = (LAS float*)(lds + AT_RPB);
    for (int i = A.tid; i < 15 * 31; i += 512) bias[i] = T.rpb[h * 15 * 31 + i] * LOG2E;
    SetState st[1]; set_init(st[0]);
    const int krlo = na_rs(R0), krhi = na_rs(R0 + 3) + 7;
    const int nt = 4 + (krhi - krlo + 1);
    const int col0 = cb == 0 ? 0 : (cb == 1 ? 8 : (cb == 2 ? 24 : 32));
    const int rs_q = na_rs(qrow); int cs_q = qcol - 8; cs_q = cs_q < 0 ? 0 : (cs_q > 48 ? 48 : cs_q);
    const int wlo = na_rs(qr0), whi = na_rs(qr0 + 1) + 7;
    tile_pipeline<false, 144>(nt, lds, A.tid,
        [&](int t, StageRegs& R) { const int rb = t < 4 ? NLAT + b * CTXL + 64 * t : b * SEQ + 64 * (krlo + t - 4);
            stage_load<false>(R, T.P + (size_t)rb * PW + PC_NK + 64 * h, PW, nullptr, 0, T.P + (size_t)rb * PW + PC_NV + 64 * h, PW, A.tid); },
        [&](LAS unsigned char* buf, int t) {
            if (t < 4) {
                f32x16 p[2]; bf16x8 pf[1][2][2]; const int subrow[2] = {0, 32};
                p[0] = qk32<4>(buf + A.q31 * 144 + A.hi * 16, qf); p[1] = qk32<4>(buf + (32 + A.q31) * 144 + A.hi * 16, qf);
                softmax_pack<2>(st[0], p, pf[0]);
                pv_step<1, 2>(st, pf, buf + AT_KBYTES + A.voff, subrow);
            } else {
                const int kr = krlo + t - 4;
                if (kr < wlo || kr > whi) return;
                f32x16 p[1]; bf16x8 pf[1][1][2]; const int subrow[1] = {col0};
                p[0] = qk32<4>(buf + (col0 + A.q31) * 144 + A.hi * 16, qf);
                const bool rv = kr >= rs_q && kr < rs_q + 8;
#pragma unroll
                for (int r = 0; r < 16; ++r) { const int kc = col0 + crow(r, A.hi); const bool ok = rv && kc >= cs_q && kc < cs_q + 16;
                    int bi = (kr - qrow + 7) * 31 + (kc - qcol + 15); bi = ok ? bi : 0;
                    p[0][r] = ok ? p[0][r] + bias[bi] : -1e30f; }
                softmax_pack<1>(st[0], p, pf[0]);
                pv_step<1, 1>(st, pf, buf + AT_KBYTES + A.voff, subrow);
            } });
    float l = st[0].l; l += __shfl_xor(l, 32); const float il = 1.f / l;
    st[0].o0 *= il; st[0].o1 *= il;
    store_o(T.O + (size_t)row * DM + 768 + 64 * h, st[0].o0, st[0].o1, A.hi);
}
__device__ __forceinline__ void attn_na_ctx(const AttnBufs& T, LAS unsigned char* lds, int b, int h) {
    const AttnLane A = make_lane();
    const int row = NLAT + b * CTXL + A.wave * 32 + A.q31;
    bf16x8 qf[4]; load_qf<4>(qf, T.P + (size_t)row * PW + PC_NQ + 64 * h, A.hi);
    SetState st[1]; set_init(st[0]);
    tile_pipeline<false, 144>(4, lds, A.tid,
        [&](int t, StageRegs& R) { const int rb = NLAT + b * CTXL + 64 * t;
            stage_load<false>(R, T.P + (size_t)rb * PW + PC_NK + 64 * h, PW, nullptr, 0, T.P + (size_t)rb * PW + PC_NV + 64 * h, PW, A.tid); },
        [&](LAS unsigned char* buf, int) {
            f32x16 p[2]; bf16x8 pf[1][2][2]; const int subrow[2] = {0, 32};
            p[0] = qk32<4>(buf + A.q31 * 144 + A.hi * 16, qf); p[1] = qk32<4>(buf + (32 + A.q31) * 144 + A.hi * 16, qf);
            softmax_pack<2>(st[0], p, pf[0]);
            pv_step<1, 2>(st, pf, buf + AT_KBYTES + A.voff, subrow); });
    float l = st[0].l; l += __shfl_xor(l, 32); const float il = 1.f / l;
    st[0].o0 *= il; st[0].o1 *= il;
    store_o(T.O + (size_t)row * DM + 768 + 64 * h, st[0].o0, st[0].o1, A.hi);
}

__device__ __forceinline__ void attn_phase(Frame& F, const AttnBufs& T) {
    for (int u = F.vcu; u < 256; u += F.G) {
        attn_mla(T, F.lds, u >> 5, (u >> 3) & 3, u & 7, false);
        attn_diff(T, F.lds, u >> 5, (u >> 3) & 3, u & 7, false);
        attn_win(T, F.lds, u >> 5, (u >> 4) & 1, u & 15, false);
        attn_na(T, F.lds, u >> 5, (u >> 3) & 3, u & 7);
    }
    if (T.need_ctx) for (int u = F.vcu; u < 128; u += F.G) {
        const int br = u & 3, w = u >> 2, b = w >> 2, x = w & 3;
        if (br == 0) attn_mla(T, F.lds, b, x, 0, true);
        else if (br == 1) attn_diff(T, F.lds, b, x, 0, true);
        else if (br == 2) attn_win(T, F.lds, b, x >> 1, x & 1, true);
        else attn_na_ctx(T, F.lds, b, x);
    }
}

__global__ void __launch_bounds__(NWAVES * 64, 2) mega(Args args) {
    extern __shared__ __attribute__((aligned(16))) unsigned char lds[];
    Frame F;
    F.lds = (LAS unsigned char*)lds; F.wave = __builtin_amdgcn_readfirstlane(threadIdx.x >> 6);
    F.G = gridDim.x; { const int bx = blockIdx.x; F.vcu = (F.G % 8 == 0) ? (bx % 8) * (F.G / 8) + bx / 8 : bx; }
    F.a = args;
    volatile LAS unsigned* MISC = (volatile LAS unsigned*)(F.lds + MISC_OFF);
    for (int u = threadIdx.x; u < (LDS_BYTES - RING_BYTES) / 4; u += NWAVES * 64) ((LAS unsigned*)(F.lds + RING_BYTES))[u] = 0u;
    __syncthreads();
    unsigned* ctl = (unsigned*)args.ws;
    XcdBarrier bar = xcd_barrier_post(ctl + CW_BAR, MISC + 8);
    unsigned char* ws = args.ws;
    const int lo = args.ph_lo, hi = args.ph_hi;
    bool first_bar = true;
#define IN(k) (lo <= (k) && (k) < hi)
#define SEAM(k) do { if (IN(k) && IN((k) + 1)) { if (first_bar) { cg::this_grid().sync(); first_bar = false; } else xcd_barrier(bar); } } while (0)
    float* modall = (float*)(ws + WS_MOD);
    float* ssq = (float*)(ws + WS_SSQ);
    bf16_t* Wt_in = (bf16_t*)(ws + WS_WIN); bf16_t* Wt_up = (bf16_t*)(ws + WS_WUP); bf16_t* Wt_g = (bf16_t*)(ws + WS_WGATE); bf16_t* Wt_b = (bf16_t*)(ws + WS_WBR);
    bf16_t* Wt_o = (bf16_t*)(ws + WS_WOUT); bf16_t* Wt_1 = (bf16_t*)(ws + WS_WFF1); bf16_t* Wt_2 = (bf16_t*)(ws + WS_WFF2);
    float* XC = (float*)(ws + WS_XC);
    int ph = 0;
    if (IN(ph)) { mod_vectors(F); convert_weights(F, 0); }
    SEAM(ph); ++ph;
    for (int l = 0; l < 2; ++l) {
        const bool need_ctx = (l == 0);
        const int nMall = NTOK / 256, nMlat = need_ctx ? NTOK / 256 : NLAT / 256;
        bf16_t* H   = l == 0 ? (bf16_t*)F.a.out : (bf16_t*)(ws + WS_H1);
        bf16_t* OY  = l == 0 ? (bf16_t*)(ws + WS_H1) : (bf16_t*)(ws + WS_BIG);
        bf16_t* Pb  = l == 0 ? (bf16_t*)(ws + WS_BIG) : (bf16_t*)(ws + WS_BIG + 32 * MiB);
        bf16_t* Qb  = l == 0 ? (bf16_t*)(ws + WS_BIG + 90 * MiB) : (bf16_t*)(ws + WS_BIG + 122 * MiB);
        bf16_t* Bc  = Pb;
        bf16_t* H2  = (bf16_t*)(ws + WS_H1);
        bf16_t* U   = Pb;
        const float* modl = modall + (size_t)l * 9 * 6144;
        float* ssq_q = ssq + (size_t)(2 * l) * NTOK; float* ssq_kv = ssq + (size_t)(2 * l + 1) * NTOK;
        const float* xlat = l == 0 ? F.a.in[I_X] : F.a.out; const float* xctx = l == 0 ? F.a.in[I_CTX] : XC;
        if (IN(ph)) { if (l == 1) convert_weights(F, 1); adaln_rows(F, xlat, xctx, NTOK, F.a.in[I_NMIX] + l * DM, modl, 0, 1, H); }
        SEAM(ph); ++ph;
        if (IN(ph)) { pg8::Prob g = pg8::plain_prob(H, DM, Wt_in, DM); pg8::StaticOrder S; S.init(nMall, PW / 256, F.G, (int)blockIdx.x);
            EpiP E{Pb, ssq_q, ssq_kv}; pg8::gemm_phase<EpiP, pg8::Prob, pg8::StaticOrder, true, true>(F.lds, g, S, E); }
        SEAM(ph); ++ph;
        if (IN(ph)) { pg8::Prob g = pg8::plain_prob(Pb, PW, Wt_up, 384); g.nt = 6; pg8::StaticOrder S; S.init(nMall, 4, F.G, (int)blockIdx.x);
            EpiUp E{Qb, ssq_q, ssq_kv}; pg8::gemm_phase<EpiUp, pg8::Prob, pg8::StaticOrder, true, true>(F.lds, g, S, E); }
        SEAM(ph); ++ph;
        if (IN(ph)) { AttnBufs T{Pb, Qb, OY, F.a.in[I_DLAM] + l * 128, F.a.in[I_SUBLN] + l * 64, F.a.in[I_SINK] + l * 4, F.a.in[I_RPB] + l * 4 * 15 * 31, l == 0 ? 0.2f : 0.35550907f, need_ctx};
            attn_phase(F, T); }
        SEAM(ph); ++ph;
        if (IN(ph)) { pg8::Prob g; g.A = (const char*)OY; g.B = (const char*)Wt_b; g.nt = 4; g.lda = DM; g.ldb = DM; g.hstepB = (size_t)128 * DM * 2;
            g.a_pm = (size_t)256 * DM * 2; g.a_pnhi = 512; g.a_sh = 2; g.b_pnlo = (size_t)256 * DM * 2; g.b_pnhi = 512; g.b_mask = 3; g.b_sh = 2;
            pg8::StaticOrder S; S.init(nMlat, 16, F.G, (int)blockIdx.x);
            EpiBf16<0> E{Bc, 4096}; pg8::gemm_phase<EpiBf16<0>, pg8::Prob, pg8::StaticOrder, true, true>(F.lds, g, S, E); }
        SEAM(ph); ++ph;
        if (IN(ph)) { pg8::Prob g; g.A = (const char*)H; g.B = (const char*)Wt_g; g.nt = 16; g.lda = DM; g.ldb = DM; g.hstepB = (size_t)2048 * DM * 2;
            g.a_pm = (size_t)256 * DM * 2; g.a_pnhi = 0; g.a_sh = 0; g.b_pnlo = (size_t)64 * DM * 2; g.b_pnhi = 0; g.b_mask = ~0; g.b_sh = 0;
            pg8::StaticOrder S; S.init(nMlat, 16, F.G, (int)blockIdx.x);
            EpiMerge E{OY, Bc, F.a.in[I_BGATE] + l * 4096}; pg8::gemm_phase<EpiMerge, pg8::Prob, pg8::StaticOrder, true, true>(F.lds, g, S, E); }
        SEAM(ph); ++ph;
        if (IN(ph)) { pg8::Prob g = pg8::plain_prob(OY, DM, Wt_o, DM); pg8::StaticOrder S; S.init(nMlat, 4, F.G, (int)blockIdx.x);
            EpiRes E{xlat, xctx, F.a.out, XC, modl + 2 * 1024}; pg8::gemm_phase<EpiRes, pg8::Prob, pg8::StaticOrder, true, true>(F.lds, g, S, E); }
        SEAM(ph); ++ph;
        if (IN(ph)) adaln_rows(F, F.a.out, XC, nMlat * 256, F.a.in[I_NFFN] + l * DM, modl, 3, 4, H2);
        SEAM(ph); ++ph;
        if (IN(ph)) { pg8::Prob g = pg8::plain_prob(H2, DM, Wt_1, DM); pg8::StaticOrder S; S.init(nMlat, 16, F.G, (int)blockIdx.x);
            EpiBf16<1> E{U, FF}; pg8::gemm_phase<EpiBf16<1>, pg8::Prob, pg8::StaticOrder, true, true>(F.lds, g, S, E); }
        SEAM(ph); ++ph;
        if (IN(ph)) { pg8::Prob g = pg8::plain_prob(U, FF, Wt_2, FF); pg8::StaticOrder S; S.init(nMlat, 4, F.G, (int)blockIdx.x);
            EpiRes E{F.a.out, XC, F.a.out, XC, modl + 5 * 1024}; pg8::gemm_phase<EpiRes, pg8::Prob, pg8::StaticOrder, true, true>(F.lds, g, S, E); }
        SEAM(ph); ++ph;
    }
    if (IN(ph)) final_norm(F);
#undef IN
#undef SEAM
}

constexpr int N_PHASES = 1 + 2 * 10 + 1;

extern "C" void kernel_launch(void* const* d_in, const int* in_sizes, int n_in, void* d_out, int out_size, void* d_ws, size_t ws_size, hipStream_t stream) {
    static int grid = 0;
    if (grid == 0) {
        int dev = 0, cus = 0, per_cu = 0;
        if (n_in != 24 || out_size != NLAT * DM || ws_size < 256 * MiB) { fprintf(stderr, "kernel_launch: unexpected shapes (n_in %d out %d ws %zu)\n", n_in, out_size, ws_size); grid = -1; return; }
        if (hipGetDevice(&dev) != hipSuccess || hipDeviceGetAttribute(&cus, hipDeviceAttributeMultiprocessorCount, dev) != hipSuccess) { grid = -1; return; }
        if (hipFuncSetAttribute((const void*)mega, hipFuncAttributeMaxDynamicSharedMemorySize, LDS_BYTES) != hipSuccess) { fprintf(stderr, "hipFuncSetAttribute failed\n"); grid = -1; return; }
        if (hipOccupancyMaxActiveBlocksPerMultiprocessor(&per_cu, (const void*)mega, NWAVES * 64, LDS_BYTES) != hipSuccess || per_cu < 1) { fprintf(stderr, "occupancy query: %d\n", per_cu); grid = -1; return; }
        (void)hipGetLastError();
        grid = cus;
    }
    if (grid < 0) return;
    (void)hipMemsetAsync(d_ws, 0, CTL_ZERO_BYTES, stream);
    Args a{};
    for (int i = 0; i < 24; ++i) a.in[i] = (const float*)d_in[i];
    a.out = (float*)d_out; a.ws = (unsigned char*)d_ws; a.ph_lo = 0; a.ph_hi = N_PHASES;
    void* kargs[] = {&a};
    hipError_t e = hipLaunchCooperativeKernel((const void*)mega, dim3(grid), dim3(NWAVES * 64), kargs, LDS_BYTES, stream);
    if (e != hipSuccess) fprintf(stderr, "cooperative launch failed: %s (grid %d)\n", hipGetErrorString(e), grid);
}
```

```cpp
#include <hip/hip_runtime.h>
#include <hip/hip_cooperative_groups.h>
#include <cstdio>
#include <cstdint>
#include <type_traits>
namespace cg = cooperative_groups;
#ifndef PROBE_ATTN
#define PROBE_ATTN 1
#endif
#ifndef PROBE_MERGE
#define PROBE_MERGE 1
#endif
#ifndef PROBE_FF1
#define PROBE_FF1 1
#endif
#ifndef PROBE_ELEM
#define PROBE_ELEM 1
#endif
#ifndef PROBE_UP
#define PROBE_UP 1
#endif
#ifndef PROBE_P0
#define PROBE_P0 1
#endif
#ifndef PROBE_NOCG
#define PROBE_NOCG 1
#endif
#ifndef REP_MLA
#define REP_MLA 1
#endif
#ifndef REP_DIFF
#define REP_DIFF 1
#endif
#ifndef REP_WIN
#define REP_WIN 1
#endif
#ifndef REP_NA
#define REP_NA 1
#endif
#ifndef PROBE_BAR
#define PROBE_BAR 0
#endif

#define LAS __attribute__((address_space(3)))
#define GAS __attribute__((address_space(1)))
#define PG8_LAS __attribute__((address_space(3)))

typedef unsigned short bf16_t;
typedef short bf16x8 __attribute__((ext_vector_type(8)));
typedef float f32x4 __attribute__((ext_vector_type(4)));
typedef float f32x2 __attribute__((ext_vector_type(2)));
typedef unsigned u32x4 __attribute__((ext_vector_type(4)));
typedef unsigned u32x2 __attribute__((ext_vector_type(2)));

constexpr int DM = 1024, NBATCH = 8, SEQ = 2048, CTXL = 256, NLAT = NBATCH * SEQ, NCTX = NBATCH * CTXL, NTOK = NLAT + NCTX, FF = 4096;
constexpr int PW = 2560;
constexpr int QW = 1024;
constexpr int INW = 2464;
constexpr int PC_CQ = 0, PC_CKV = 256, PC_KR = 384, PC_DQ = 512, PC_DK = 768, PC_DV = 1024, PC_WQ = 1280, PC_WK = 1536, PC_WV = 1664, PC_NQ = 1792, PC_NK = 2048, PC_NV = 2304;
constexpr int UC_KV = 384;
constexpr float LOG2E = 1.4426950408889634f;
constexpr float MLA_SC = 0.10206207261596577f * LOG2E;
constexpr float DIFF_SC = 0.17677669529663687f * LOG2E;
constexpr float WIN_SC = 0.125f * LOG2E, NA_SC = 0.125f * LOG2E;
constexpr float EPS = 1e-6f;

enum { I_X = 0, I_C, I_CTX, I_CCTX, I_WADA, I_BADA, I_NMIX, I_NFFN, I_WIN, I_QNORM, I_KVNORM, I_WUQ, I_WUKV, I_DLAM, I_SUBLN, I_SINK, I_RPB, I_WGATE, I_BGATE, I_WBR, I_WOUT, I_FF1, I_FF2, I_FNORM };

constexpr size_t MiB = 1u << 20;
constexpr size_t CTL_ZERO_BYTES = 4 * MiB;
constexpr int CW_BAR = 4096;
constexpr size_t WS_SSQ = 64 * 1024;
constexpr size_t WS_MOD = 1 * MiB;
constexpr size_t WS_WIN = 4 * MiB, WS_WUP = 9 * MiB, WS_WGATE = 10 * MiB, WS_WBR = 18 * MiB, WS_WOUT = 20 * MiB, WS_WFF1 = 22 * MiB, WS_WFF2 = 30 * MiB;
constexpr size_t WS_XC = 38 * MiB, WS_W2L1 = 248 * MiB;
constexpr size_t WS_BIAS = 2 * MiB;
constexpr int BIASW = 2560 + 4096 + 4096, BIAS_G = 2560, BIAS_F = 2560 + 4096;
static_assert(WS_SSQ + (size_t)8 * NTOK * 4 <= CTL_ZERO_BYTES, "ssq inside memset region");

constexpr int NWAVES = 8;
constexpr int RING_BYTES = 131072;
constexpr int MISC_OFF = RING_BYTES + 320;
constexpr int LDS_BYTES = 147456;

__device__ const float ROPE_COS32[512] = {1.0f,1.0f,1.0f,1.0f,1.0f,1.0f,1.0f,1.0f,0.540302277f,0.950415254f,0.995004177f,0.999500036f,0.999949992f,0.999994993f,0.999999523f,0.99999994f,-0.416146845f,0.806578398f,0.980066597f,0.998000681f,0.999800026f,0.999979973f,0.999997973f,0.999999821f,-0.989992499f,0.582753599f,0.955336511f,0.995503366f,0.999550045f,0.999954998f,0.99999553f,0.999999523f,-0.653643608f,0.301137477f,0.921060979f,0.992010653f,0.999200106f,0.999920011f,0.999992013f,0.999999225f,0.2836622f,-0.0103423186f,0.87758255f,0.987526f,0.998750269f,0.999875009f,0.999987483f,0.999998748f,0.960170269f,-0.32079646f,0.825335622f,0.982053936f,0.998200536f,0.999819994f,0.999981999f,0.999998212f,0.753902256f,-0.599437416f,0.764842212f,0.975599885f,0.997551024f,0.999755025f,0.999975502f,0.999997556f,-0.145500034f,-0.818632483f,0.696706712f,0.968170285f,0.996801734f,0.999680042f,0.999967992f,0.999996781f,-0.91113025f,-0.956644177f,0.621609986f,0.959772646f,0.995952725f,0.999595046f,0.999959528f,0.999995947f,-0.839071512f,-0.999786079f,0.540302277f,0.950415254f,0.995004177f,0.999500036f,0.999949992f,0.999994993f,0.00442569796f,-0.943779707f,0.453596115f,0.940107584f,0.993956089f,0.999395072f,0.999939501f,0.99999392f,0.843853951f,-0.794179261f,0.362357765f,0.92885989f,0.99280864f,0.999280095f,0.999927998f,0.999992788f,0.907446802f,-0.565820515f,0.267498821f,0.916683376f,0.99156189f,0.999155104f,0.999915481f,0.999991536f,0.136737213f,-0.281349629f,0.169967145f,0.903590262f,0.990216017f,0.999020159f,0.99990201f,0.999990225f,-0.759687901f,0.0310225319f,0.070737198f,0.889593601f,0.988771081f,0.998875201f,0.999887526f,0.999988735f,-0.957659483f,0.340318203f,-0.029199522f,0.87470746f,0.987227261f,0.998720288f,0.999872029f,0.999987185f,-0.275163352f,0.615864694f,-0.1288445f,0.858946681f,0.985584795f,0.998555362f,0.999855518f,0.999985576f,0.660316706f,0.830336273f,-0.227202088f,0.842327058f,0.983843684f,0.998380423f,0.999837995f,0.999983788f,0.988704622f,0.962463796f,-0.323289573f,0.824865103f,0.982004225f,0.998195529f,0.999819517f,0.99998194f,0.408082068f,0.999144375f,-0.416146845f,0.806578398f,0.980066597f,0.998000681f,0.999800026f,0.999979973f,-0.547729254f,0.936740339f,-0.504846096f,0.787485182f,0.97803092f,0.99779582f,0.999779522f,0.999977946f,-0.99996084f,0.781440318f,-0.588501096f,0.76760453f,0.975897431f,0.997581005f,0.999758005f,0.999975801f,-0.53283304f,0.548645318f,-0.666276038f,0.746956348f,0.97366637f,0.997356176f,0.999735534f,0.999973536f,0.424179018f,0.26144141f,-0.737393737f,0.725561321f,0.971337974f,0.997121394f,0.99971199f,0.999971211f,0.991202831f,-0.051689472f,-0.801143587f,0.703440726f,0.968912423f,0.996876657f,0.999687493f,0.999968767f,0.64691931f,-0.359694332f,-0.856888771f,0.680616736f,0.966389954f,0.996621907f,0.999662042f,0.999966204f,-0.292138815f,-0.63202852f,-0.904072165f,0.657112241f,0.963770926f,0.996357203f,0.999635518f,0.999963522f,-0.962605894f,-0.841684759f,-0.942222357f,0.632950664f,0.961055458f,0.996082544f,0.99960804f,0.99996078f,-0.748057544f,-0.967871606f,-0.970958173f,0.608156204f,0.958243847f,0.995797932f,0.999579549f,0.999957979f,0.154251456f,-0.998075187f,-0.989992499f,0.582753599f,0.955336511f,0.995503366f,0.999550045f,0.999954998f,0.914742351f,-0.929300189f,-0.999135137f,0.556768298f,0.95233357f,0.995198846f,0.999519527f,0.999951959f,0.83422339f,-0.768367052f,-0.998294771f,0.53022635f,0.949235439f,0.994884372f,0.999488056f,0.9999488f,-0.0132767474f,-0.531235337f,-0.987479746f,0.503154159f,0.946042359f,0.994559944f,0.999455571f,0.999945521f,-0.848570287f,-0.241421327f,-0.966798186f,0.475578845f,0.942754686f,0.994225562f,0.999422073f,0.999942183f,-0.903692186f,0.072334297f,-0.93645668f,0.447528005f,0.939372718f,0.993881226f,0.999387562f,0.999938726f,-0.127963692f,0.378916562f,-0.896758437f,0.419029653f,0.935896814f,0.993526995f,0.999352098f,0.99993521f,0.765414059f,0.64792192f,-0.848100007f,0.39011234f,0.93232733f,0.993162811f,0.99931556f,0.999931574f,0.955073655f,0.852673173f,-0.790967703f,0.360804945f,0.928664625f,0.992788672f,0.999278069f,0.999927819f,0.266642928f,0.972865343f,-0.7259323f,0.331136763f,0.924909055f,0.99240464f,0.999239624f,0.999923944f,-0.666938066f,0.996578991f,-0.653643608f,0.301137477f,0.921060979f,0.992010653f,0.999200106f,0.999920011f,-0.987339258f,0.921462476f,-0.574823976f,0.270837069f,0.917120814f,0.991606772f,0.999159634f,0.999915957f,-0.399985313f,0.754965007f,-0.49026081f,0.240265846f,0.913088918f,0.991192937f,0.999118149f,0.999911785f,0.555113316f,0.513598084f,-0.400799185f,0.209454387f,0.908965766f,0.990769207f,0.999075651f,0.999907553f,0.999843299f,0.221297964f,-0.307332873f,0.178433478f,0.904751658f,0.990335584f,0.99903214f,0.999903202f,0.52532196f,-0.0929481685f,-0.210795805f,0.147234172f,0.90044713f,0.989892066f,0.998987675f,0.999898732f,-0.432177931f,-0.397976696f,-0.112152524f,0.115887627f,0.89605248f,0.989438653f,0.998942196f,0.999894202f,-0.992335498f,-0.663538098f,-0.0123886634f,0.084425211f,0.891568303f,0.988975346f,0.998895705f,0.999889553f,-0.640144348f,-0.863296807f,0.0874989852f,0.0528783761f,0.886994898f,0.988502085f,0.9988482f,0.999884784f,0.300592542f,-0.977442801f,0.186512366f,0.0212786663f,0.882332861f,0.98801899f,0.998799741f,0.999879956f,0.964965999f,-0.994656384f,0.2836622f,-0.0103423186f,0.87758255f,0.987526f,0.998750269f,0.999875009f,0.742154181f,-0.913230479f,0.377977729f,-0.0419529639f,0.872744501f,0.987023175f,0.998699784f,0.999869943f,-0.162990779f,-0.741239965f,0.468516678f,-0.0735216588f,0.86781919f,0.986510456f,0.998648286f,0.999864817f,-0.918282807f,-0.495741129f,0.554374337f,-0.105016835f,0.862807095f,0.985987842f,0.998595834f,0.999859571f,-0.829309821f,-0.20107992f,0.634692848f,-0.136407003f,0.857708693f,0.985455394f,0.998542368f,0.999854207f,0.0221267566f,0.113522276f,0.708669782f,-0.167660788f,0.852524519f,0.984913111f,0.99848789f,0.999848783f,0.853220105f,0.416866541f,0.775565863f,-0.19874692f,0.847255111f,0.984360933f,0.998432398f,0.99984318f,0.899866819f,0.67887038f,0.834712803f,-0.229634315f,0.841901004f,0.983798921f,0.998375952f,0.999837577f,0.119180135f,0.873551011f,0.885519505f,-0.260292083f,0.836462677f,0.983227074f,0.998318493f,0.999831796f,-0.771080196f,0.981602073f,0.927478433f,-0.290689617f,0.830940664f,0.982645452f,0.998260021f,0.999825954f,-0.952412963f,0.992308259f,0.960170269f,-0.32079646f,0.825335622f,0.982053936f,0.998200536f,0.999819994f,-0.258101642f,0.904607713f,0.98326844f,-0.35058254f,0.819648027f,0.981452644f,0.998140097f,0.999813974f,0.673507154f,0.727197766f,0.996542096f,-0.380018055f,0.813878477f,0.980841517f,0.998078644f,0.999807835f,0.985896587f,0.47767204f,0.999858618f,-0.409073591f,0.808027506f,0.980220556f,0.998016179f,0.999801576f};
__device__ const float ROPE_SIN32[512] = {0.0f,0.0f,0.0f,0.0f,0.0f,0.0f,0.0f,0.0f,0.841470957f,0.310983598f,0.099833414f,0.0316175073f,0.00999983307f,0.00316227227f,0.000999999815f,0.000316227757f,0.909297407f,0.591127098f,0.198669329f,0.0632033944f,0.0199986659f,0.00632451335f,0.0019999987f,0.000632455514f,0.141120002f,0.812648892f,0.295520216f,0.0947260931f,0.029995501f,0.00948669109f,0.0029999956f,0.000948683184f,-0.756802499f,0.953580737f,0.389418334f,0.126154065f,0.0399893336f,0.0126487734f,0.00399998948f,0.00126491068f,-0.958924294f,0.999946535f,0.47942555f,0.157455891f,0.0499791689f,0.0158107299f,0.0049999794f,0.00158113812f,-0.279415488f,0.947148144f,0.564642489f,0.188600287f,0.0599640049f,0.0189725272f,0.0059999642f,0.00189736544f,0.656986594f,0.800421655f,0.64421767f,0.219556093f,0.0699428469f,0.0221341364f,0.00699994294f,0.00221359264f,0.989358246f,0.574317753f,0.717356086f,0.250292361f,0.0799146965f,0.0252955221f,0.0079999147f,0.0025298195f,0.412118495f,0.29125911f,0.783326924f,0.280778348f,0.0898785517f,0.0284566563f,0.00899987854f,0.00284604612f,-0.54402113f,-0.0206835307f,0.841470957f,0.310983598f,0.099833414f,0.0316175073f,0.00999983307f,0.00316227227f,-0.999990225f,-0.330575019f,0.891207337f,0.340877861f,0.1097783f,0.0347780399f,0.0109997783f,0.00347849843f,-0.536572933f,-0.607683539f,0.932039082f,0.370431304f,0.119712204f,0.037938226f,0.0119997123f,0.00379472412f,0.420167029f,-0.824528456f,0.963558197f,0.399614334f,0.129634142f,0.0410980321f,0.0129996343f,0.00411094958f,0.990607381f,-0.959605336f,0.985449731f,0.428397804f,0.139543116f,0.0442574248f,0.0139995422f,0.00442717411f,0.650287867f,-0.999518692f,0.997494996f,0.456752867f,0.149438128f,0.0474163778f,0.0149994371f,0.00474339863f,-0.287903309f,-0.940310359f,0.999573588f,0.484651268f,0.159318209f,0.0505748577f,0.0159993172f,0.00505962269f,-0.961397469f,-0.78785193f,0.991664827f,0.512064993f,0.169182345f,0.053732831f,0.0169991814f,0.00537584629f,-0.750987232f,-0.557262719f,0.973847628f,0.538966775f,0.179029569f,0.0568902642f,0.0179990288f,0.00569206895f,0.149877205f,-0.271410018f,0.946300089f,0.565329552f,0.188858896f,0.060047131f,0.0189988576f,0.00600829162f,0.912945271f,0.0413582139f,0.909297407f,0.591127098f,0.198669329f,0.0632033944f,0.0199986659f,0.00632451335f,0.836655617f,0.350024998f,0.863209367f,0.616333604f,0.208459899f,0.0663590282f,0.0209984574f,0.00664073415f,-0.00885130931f,0.623979986f,0.808496416f,0.640923738f,0.218229622f,0.0695139989f,0.0219982248f,0.00695695495f,-0.846220434f,0.836055219f,0.745705187f,0.664873064f,0.227977529f,0.0726682767f,0.0229979716f,0.00727317436f,-0.905578375f,0.965219319f,0.6754632f,0.688157558f,0.237702623f,0.0758218244f,0.0239976961f,0.0075893933f,-0.132351756f,0.998663187f,0.598472118f,0.710753918f,0.247403964f,0.0789746195f,0.0249973964f,0.00790561177f,0.76255846f,0.933070183f,0.51550138f,0.732639611f,0.257080555f,0.0821266174f,0.0259970706f,0.00822182931f,0.956375957f,0.77494514f,0.427379876f,0.753792763f,0.266731441f,0.0852777958f,0.0269967187f,0.00853804592f,0.270905793f,0.539969206f,0.334988147f,0.774192154f,0.276355654f,0.0884281248f,0.0279963408f,0.0088542616f,-0.663633883f,0.251444817f,0.239249334f,0.793817401f,0.28595221f,0.0915775672f,0.0289959349f,0.00917047635f,-0.988031626f,-0.0620152019f,0.141120002f,0.812648892f,0.295520216f,0.0947260931f,0.029995501f,0.00948669109f,-0.404037654f,-0.369325221f,0.0415806621f,0.830667794f,0.305058628f,0.0978736728f,0.0309950355f,0.00980290398f,0.551426709f,-0.640009463f,-0.0583741441f,0.847856164f,0.314566553f,0.101020269f,0.0319945402f,0.0101191159f,0.999911845f,-0.847224295f,-0.157745689f,0.864196718f,0.324043036f,0.10416586f,0.0329940096f,0.010435327f,0.529082716f,-0.97042042f,-0.255541116f,0.879673123f,0.333487093f,0.107310407f,0.0339934491f,0.010751537f,-0.428182662f,-0.997380435f,-0.350783229f,0.894269943f,0.342897803f,0.110453889f,0.034992855f,0.0110677462f,-0.991778851f,-0.925430834f,-0.44252044f,0.907972574f,0.352274239f,0.113596253f,0.0359922238f,0.0113839535f,-0.643538117f,-0.761706769f,-0.529836118f,0.920767248f,0.361615419f,0.116737492f,0.036991559f,0.0117001608f,0.296368569f,-0.522444665f,-0.611857891f,0.932641327f,0.370920479f,0.119877562f,0.0379908569f,0.0120163662f,0.963795364f,-0.231372029f,-0.687766135f,0.943582773f,0.380188406f,0.123016424f,0.0389901139f,0.0123325698f,0.745113134f,0.0826456547f,-0.756802499f,0.953580737f,0.389418334f,0.126154065f,0.0399893336f,0.0126487734f,-0.158622667f,0.388467401f,-0.818277121f,0.962625206f,0.39860934f,0.129290447f,0.0409885123f,0.0129649751f,-0.916521549f,0.655765057f,-0.871575773f,0.970707119f,0.407760441f,0.132425532f,0.0419876538f,0.0132811759f,-0.831774771f,0.858030856f,-0.916165948f,0.977818429f,0.416870803f,0.135559291f,0.0429867506f,0.0135973748f,0.0177019257f,0.975206256f,-0.951602101f,0.983951986f,0.425939471f,0.138691694f,0.0439858027f,0.0139135728f,0.850903511f,0.995670974f,-0.977530122f,0.989101648f,0.434965521f,0.141822711f,0.0449848138f,0.0142297689f,0.901788354f,0.917395532f,-0.993691027f,0.993262351f,0.44394812f,0.144952312f,0.0459837802f,0.0145459641f,0.123573124f,0.748142481f,-0.999923229f,0.996429801f,0.452886283f,0.148080453f,0.0469826981f,0.0148621574f,-0.768254638f,0.504696608f,-0.99616462f,0.99860096f,0.461779177f,0.151207134f,0.0479815714f,0.0151783498f,-0.953752637f,0.211200237f,-0.982452631f,0.999773562f,0.470625877f,0.15433228f,0.0489803925f,0.0154945403f,-0.262374848f,-0.103240743f,-0.958924294f,0.999946535f,0.47942555f,0.157455891f,0.0499791689f,0.0158107299f,0.670229197f,-0.407443404f,-0.925814688f,0.99911958f,0.48817724f,0.160577938f,0.0509778932f,0.0161269177f,0.986627579f,-0.671240151f,-0.88345468f,0.997293591f,0.496880144f,0.163698375f,0.051976569f,0.0164431036f,0.395925164f,-0.868470371f,-0.832267463f,0.994470417f,0.505533338f,0.166817173f,0.0529751889f,0.0167592876f,-0.558789074f,-0.979574859f,-0.772764504f,0.990652859f,0.514136016f,0.169934288f,0.0539737605f,0.0170754697f,-0.999755144f,-0.993535459f,-0.705540299f,0.985844731f,0.522687256f,0.173049718f,0.0549722761f,0.01739165f,-0.521551013f,-0.908967733f,-0.631266654f,0.980050862f,0.531186223f,0.17616342f,0.0559707358f,0.0177078284f,0.436164767f,-0.734258175f,-0.550685525f,0.973276973f,0.539632022f,0.179275364f,0.0569691397f,0.0180240069f,0.992872655f,-0.486732632f,-0.464602172f,0.965529919f,0.548023939f,0.182385504f,0.0579674877f,0.0183401816f,0.636738002f,-0.190938085f,-0.373876661f,0.956817389f,0.55636102f,0.185493827f,0.0589657761f,0.0186563563f,-0.304810613f,0.123791665f,-0.279415488f,0.947148144f,0.564642489f,0.188600287f,0.0599640049f,0.0189725272f,-0.966117799f,0.426245064f,-0.182162508f,0.936531842f,0.572867453f,0.191704869f,0.0609621778f,0.0192886982f,-0.739180684f,0.68642801f,-0.0830894038f,0.924979091f,0.581035137f,0.194807529f,0.0619602874f,0.0196048655f,0.167355701f,0.878538251f,0.0168139003f,0.912501395f,0.589144766f,0.197908238f,0.0629583374f,0.0199210308f};
__device__ const float ROPE_COS64[1024] = {1.0f,1.0f,1.0f,1.0f,1.0f,1.0f,1.0f,1.0f,1.0f,1.0f,1.0f,1.0f,1.0f,1.0f,1.0f,1.0f,0.540302277f,0.846009135f,0.950415254f,0.98423022f,0.995004177f,0.998419285f,0.999500036f,0.999841869f,0.999949992f,0.999984205f,0.999994993f,0.999998391f,0.999999523f,0.999999821f,0.99999994f,1.0f,-0.416146845f,0.431462824f,0.806578398f,0.937418282f,0.980066597f,0.993682086f,0.998000681f,0.999367595f,0.999800026f,0.999936759f,0.999979973f,0.999993682f,0.999997973f,0.999999344f,0.999999821f,0.99999994f,-0.989992499f,-0.115966141f,0.582753599f,0.861040652f,0.955336511f,0.985803485f,0.995503366f,0.998577297f,0.999550045f,0.999857724f,0.999954998f,0.999985754f,0.99999553f,0.999998569f,0.999999523f,0.999999881f,-0.653643608f,-0.627679646f,0.301137477f,0.757506192f,0.921060979f,0.974808276f,0.992010653f,0.997471273f,0.999200106f,0.999747038f,0.999920011f,0.999974728f,0.999992013f,0.999997497f,0.999999225f,0.999999762f,0.2836622f,-0.946079254f,-0.0103423186f,0.630080283f,0.87758255f,0.960731268f,0.987526f,0.996049762f,0.998750269f,0.999604762f,0.999875009f,0.999960482f,0.999987483f,0.999996066f,0.999998748f,0.999999583f,0.960170269f,-0.973103702f,-0.32079646f,0.482782006f,0.825335622f,0.943616986f,0.982053936f,0.9943133f,0.998200536f,0.999430835f,0.999819994f,0.999943078f,0.999981999f,0.999994338f,0.999998212f,0.999999404f,0.753902256f,-0.700429916f,-0.599437416f,0.320256978f,0.764842212f,0.923519433f,0.975599885f,0.992262423f,0.997551024f,0.999225318f,0.999755025f,0.999922514f,0.999975502f,0.999992251f,0.999997556f,0.999999225f,-0.145500034f,-0.212036505f,-0.818632483f,0.147631198f,0.696706712f,0.900502324f,0.968170285f,0.989897788f,0.996801734f,0.998988271f,0.999680042f,0.999898791f,0.999967992f,0.999989867f,0.999996781f,0.999998987f,-0.91113025f,0.341660321f,-0.956644177f,-0.0296507962f,0.621609986f,0.874638259f,0.959772646f,0.987220109f,0.995952725f,0.998719573f,0.999595046f,0.99987191f,0.999959528f,0.999987185f,0.999995947f,0.999998748f,-0.839071512f,0.790131986f,-0.999786079f,-0.205997616f,0.540302277f,0.846009135f,0.950415254f,0.98423022f,0.995004177f,0.998419285f,0.999500036f,0.999841869f,0.999949992f,0.999984205f,0.999994993f,0.999998391f,0.00442569796f,0.995257378f,-0.943779707f,-0.375847369f,0.453596115f,0.814705312f,0.940107584f,0.980929136f,0.993956089f,0.998087406f,0.999395072f,0.999808669f,0.999939501f,0.999980867f,0.99999392f,0.999998093f,0.843853951f,0.893861651f,-0.794179261f,-0.5338431f,0.362357765f,0.780825913f,0.92885989f,0.97731787f,0.99280864f,0.997723997f,0.999280095f,0.99977231f,0.999927998f,0.999977231f,0.999992788f,0.999997735f,0.907446802f,0.517172813f,-0.565820515f,-0.675001621f,0.267498821f,0.744477987f,0.916683376f,0.973397553f,0.99156189f,0.997329056f,0.999155104f,0.999732792f,0.999915481f,0.999973297f,0.999991536f,0.999997318f,0.136737213f,-0.0187958125f,-0.281349629f,-0.794870913f,0.169967145f,0.705776393f,0.903590262f,0.969169438f,0.990216017f,0.996902585f,0.999020159f,0.999690115f,0.99990201f,0.999969006f,0.999990225f,0.999996901f,-0.759687901f,-0.548975706f,0.0310225319f,-0.889670372f,0.070737198f,0.664843559f,0.889593601f,0.964634836f,0.988771081f,0.996444523f,0.998875201f,0.999644279f,0.999887526f,0.999964416f,0.999988735f,0.999996424f,-0.957659483f,-0.910081029f,0.340318203f,-0.95641005f,-0.029199522f,0.621808827f,0.87470746f,0.959795177f,0.987227261f,0.99595499f,0.998720288f,0.999595284f,0.999872029f,0.999959528f,0.999987185f,0.999995947f,-0.275163352f,-0.990898013f,0.615864694f,-0.99298501f,-0.1288445f,0.576808274f,0.858946681f,0.954652011f,0.985584795f,0.995433986f,0.998555362f,0.999543071f,0.999855518f,0.999954283f,0.999985576f,0.99999541f,0.660316706f,-0.766536474f,0.830336273f,-0.998241663f,-0.227202088f,0.529984236f,0.842327058f,0.949207008f,0.983843684f,0.994881511f,0.998380423f,0.999487758f,0.999837995f,0.9999488f,0.999983788f,0.999994874f,0.988704622f,-0.30609566f,0.962463796f,-0.972014248f,-0.323289573f,0.481484622f,0.824865103f,0.943461835f,0.982004225f,0.994297504f,0.998195529f,0.999429286f,0.999819517f,0.999942899f,0.99998194f,0.999994278f,0.408082068f,0.248617053f,0.999144375f,-0.91512996f,-0.416146845f,0.431462824f,0.806578398f,0.937418282f,0.980066597f,0.993682086f,0.998000681f,0.999367595f,0.999800026f,0.999936759f,0.999979973f,0.999993682f,-0.547729254f,0.726760209f,0.936740339f,-0.829382896f,-0.504846096f,0.380077004f,0.787485182f,0.931078374f,0.97803092f,0.993035257f,0.99779582f,0.999302804f,0.999779522f,0.999930263f,0.999977946f,0.999993026f,-0.99996084f,0.981074512f,0.781440318f,-0.7174775f,-0.588501096f,0.327489585f,0.76760453f,0.92444396f,0.975897431f,0.992357016f,0.997581005f,0.999234855f,0.999758005f,0.999923468f,0.999975801f,0.999992371f,-0.53283304f,0.933235705f,0.548645318f,-0.582943201f,-0.666276038f,0.273866832f,0.746956348f,0.917517304f,0.97366637f,0.991647422f,0.997356176f,0.999163687f,0.999735534f,0.999916375f,0.999973536f,0.999991655f,0.424179018f,0.597977281f,0.26144141f,-0.430023134f,-0.737393737f,0.219378248f,0.725561321f,0.910300434f,0.971337974f,0.990906477f,0.997121394f,0.99908942f,0.99971199f,0.999908924f,0.999971211f,0.99999088f,0.991202831f,0.0785527974f,-0.051689472f,-0.263540328f,-0.801143587f,0.164196119f,0.703440726f,0.902795732f,0.968912423f,0.99013412f,0.996876657f,0.999011934f,0.999687493f,0.999901175f,0.999968767f,0.999990106f,0.64691931f,-0.465064526f,-0.359694332f,-0.0887456089f,-0.856888771f,0.108494893f,0.680616736f,0.895005584f,0.966389954f,0.98933053f,0.996621907f,0.998931348f,0.999662042f,0.999893129f,0.999966204f,0.999989331f,-0.292138815f,-0.865450501f,-0.63202852f,0.088848114f,-0.904072165f,0.0524506681f,0.657112241f,0.886932373f,0.963770926f,0.988495648f,0.996357203f,0.998847544f,0.999635518f,0.999884725f,0.999963522f,0.999988496f,-0.962605894f,-0.999293447f,-0.841684759f,0.263639599f,-0.942222357f,-0.00375937484f,0.632950664f,0.878578722f,0.961055458f,0.987629473f,0.996082544f,0.998760641f,0.99960804f,0.999876022f,0.99996078f,0.999987602f,-0.748057544f,-0.825372219f,-0.967871606f,0.430116028f,-0.970958173f,-0.0599575341f,0.608156204f,0.869947255f,0.958243847f,0.986732066f,0.995797932f,0.998670578f,0.999579549f,0.999867022f,0.999957979f,0.999986708f,0.154251456f,-0.397251397f,-0.998075187f,0.583026826f,-0.989992499f,-0.115966141f,0.582753599f,0.861040652f,0.955336511f,0.985803485f,0.995503366f,0.998577297f,0.999550045f,0.999857724f,0.999954998f,0.999985754f,0.914742351f,0.153215602f,-0.929300189f,0.717549205f,-0.999135137f,-0.171608135f,0.556768298f,0.851861775f,0.95233357f,0.984843671f,0.995198846f,0.998480916f,0.999519527f,0.999848068f,0.999951959f,0.999984801f,0.83422339f,0.656494975f,-0.768367052f,0.829440415f,-0.998294771f,-0.226707578f,0.53022635f,0.842413545f,0.949235439f,0.983852804f,0.994884372f,0.998381376f,0.999488056f,0.999838114f,0.9999488f,0.999983788f,-0.0132767474f,0.957585931f,-0.531235337f,0.915171444f,-0.987479746f,-0.281090319f,0.503154159f,0.832698941f,0.946042359f,0.982830763f,0.994559944f,0.998278618f,0.999455571f,0.999827802f,0.999945521f,0.999982774f,-0.848570287f,0.963757813f,-0.241421327f,0.972038448f,-0.966798186f,-0.334584415f,0.475578845f,0.822721004f,0.942754686f,0.981777668f,0.994225562f,0.99817276f,0.999422073f,0.999817252f,0.999942183f,0.999981701f,-0.903692186f,0.673109829f,0.072334297f,0.998247743f,-0.93645668f,-0.387020707f,0.447528005f,0.812482893f,0.939372718f,0.980693519f,0.993881226f,0.998063743f,0.999387562f,0.999806345f,0.999938726f,0.999980628f,-0.127963692f,0.175156325f,0.378916562f,0.992972851f,-0.896758437f,-0.438233495f,0.419029653f,0.801987886f,0.935896814f,0.979578316f,0.993526995f,0.997951567f,0.999352098f,0.999795079f,0.99993521f,0.999979496f,0.765414059f,-0.376742154f,0.64792192f,0.95638001f,-0.848100007f,-0.488060802f,0.39011234f,0.791239262f,0.93232733f,0.978432178f,0.993162811f,0.997836173f,0.99931556f,0.999783576f,0.999931574f,0.999978364f,0.955073655f,-0.812610924f,0.852673173f,0.889623404f,-0.790967703f,-0.536345124f,0.360804945f,0.780240476f,0.928664625f,0.977255106f,0.992788672f,0.997717679f,0.999278069f,0.999771714f,0.999927819f,0.999977171f,0.266642928f,-0.998210311f,0.972865343f,0.794808507f,-0.7259323f,-0.582933843f,0.331136763f,0.768994868f,0.924909055f,0.976047099f,0.99240464f,0.997596025f,0.999239624f,0.999759495f,0.999923944f,0.999975979f,-0.666938066f,-0.876379132f,0.996578991f,0.674925685f,-0.653643608f,-0.627679646f,0.301137477f,0.757506192f,0.921060979f,0.974808276f,0.992010653f,0.997471273f,0.999200106f,0.999747038f,0.999920011f,0.999974728f,-0.987339258f,-0.484639138f,0.921462476f,0.533756077f,-0.574823976f,-0.670441091f,0.270837069f,0.745777905f,0.917120814f,0.973538578f,0.991606772f,0.997343302f,0.999159634f,0.999734223f,0.999915957f,0.999973416f,-0.399985313f,0.0563608743f,0.754965007f,0.375752002f,-0.49026081f,-0.711082935f,0.240265846f,0.733813822f,0.913088918f,0.972238123f,0.991192937f,0.997212172f,0.999118149f,0.99972111f,0.999911785f,0.999972105f,0.555113316f,0.580002785f,0.513598084f,0.205896914f,-0.400799185f,-0.74947679f,0.209454387f,0.721617699f,0.908965766f,0.970906913f,0.990769207f,0.997077882f,0.999075651f,0.999707639f,0.999907553f,0.999970794f,0.999843299f,0.925014377f,0.221297964f,0.0295479279f,-0.307332873f,-0.785501122f,0.178433478f,0.709193349f,0.904751658f,0.969545007f,0.990335584f,0.996940494f,0.99903214f,0.99969393f,0.999903202f,0.999969363f,0.52532196f,0.985138416f,-0.0929481685f,-0.147732988f,-0.210795805f,-0.819042206f,0.147234172f,0.696544766f,0.90044713f,0.968152463f,0.989892066f,0.996799886f,0.998987675f,0.999679863f,0.999898732f,0.999967992f,-0.432177931f,0.741857767f,-0.397976696f,-0.320354462f,-0.112152524f,-0.849993944f,0.115887627f,0.683675885f,0.89605248f,0.966729224f,0.989438653f,0.996656179f,0.998942196f,0.999665439f,0.999894202f,0.999966562f,-0.992335498f,0.270098448f,-0.663538098f,-0.482872128f,-0.0123886634f,-0.878258407f,0.084425211f,0.670590878f,0.891568303f,0.965275466f,0.988975346f,0.996509314f,0.998895705f,0.999650776f,0.999889553f,0.999965072f,-0.640144348f,-0.284846276f,-0.863296807f,-0.630160213f,0.0874989852f,-0.903746367f,0.0528783761f,0.657293797f,0.886994898f,0.963791192f,0.988502085f,0.996359289f,0.9988482f,0.999635756f,0.999884784f,0.999963582f,0.300592542f,-0.752063513f,-0.977442801f,-0.757573366f,0.186512366f,-0.926377177f,0.0212786663f,0.643788815f,0.882332861f,0.962276459f,0.98801899f,0.996206105f,0.998799741f,0.999620378f,0.999879956f,0.999962032f,0.964965999f,-0.987658918f,-0.994656384f,-0.861092985f,0.2836622f,-0.946079254f,-0.0103423186f,0.630080283f,0.87758255f,0.960731268f,0.987526f,0.996049762f,0.998750269f,0.999604762f,0.999875009f,0.999960482f,0.742154181f,-0.919073343f,-0.913230479f,-0.937454164f,0.377977729f,-0.96279037f,-0.0419529639f,0.616172552f,0.872744501f,0.959155679f,0.987023175f,0.99589026f,0.998699784f,0.999588788f,0.999869943f,0.999958873f,-0.162990779f,-0.56742996f,-0.741239965f,-0.984248459f,0.468516678f,-0.976457715f,-0.0735216588f,0.602069914f,0.86781919f,0.95754981f,0.986510456f,0.995727658f,0.998648286f,0.999572515f,0.999864817f,0.999957263f,-0.918282807f,-0.0410284549f,-0.495741129f,-1.0f,0.554374337f,-0.987038016f,-0.105016835f,0.587776899f,0.862807095f,0.955913603f,0.985987842f,0.995561838f,0.998595834f,0.999555886f,0.999859571f,0.999955595f,-0.829309821f,0.498009056f,-0.20107992f,-0.984212041f,0.634692848f,-0.994497836f,-0.136407003f,0.573298037f,0.857708693f,0.954247177f,0.985455394f,0.995392919f,0.998542368f,0.999538958f,0.999854207f,0.999953866f,0.0221267566f,0.88366884f,0.113522276f,-0.93738246f,0.708669782f,-0.998813629f,-0.167660788f,0.558637917f,0.852524519f,0.95255059f,0.984913111f,0.99522084f,0.99848789f,0.999521732f,0.999848783f,0.999952197f,0.853220105f,0.99717474f,0.416866541f,-0.860988319f,0.775565863f,-0.999971747f,-0.19874692f,0.543801129f,0.847255111f,0.950823903f,0.984360933f,0.995045662f,0.998432398f,0.999504209f,0.99984318f,0.999950409f,0.899866819f,0.803568959f,0.67887038f,-0.757438958f,0.834712803f,-0.997968495f,-0.229634315f,0.528792322f,0.841901004f,0.949067116f,0.983798921f,0.994867265f,0.998375952f,0.999486327f,0.999837577f,0.999948621f,0.119180135f,0.362478614f,0.873551011f,-0.630000412f,0.885519505f,-0.99281019f,-0.260292083f,0.513616383f,0.836462677f,0.947280347f,0.983227074f,0.994685769f,0.998318493f,0.999468148f,0.999831796f,0.999946833f,-0.771080196f,-0.190248564f,0.981602073f,-0.482691884f,0.927478433f,-0.984513164f,-0.290689617f,0.498277962f,0.830940664f,0.945463598f,0.982645452f,0.994501114f,0.998260021f,0.99944967f,0.999825954f,0.999944985f,-0.952412963f,-0.684382617f,0.992308259f,-0.320159495f,0.960170269f,-0.973103702f,-0.32079646f,0.482782006f,0.825335622f,0.943616986f,0.982053936f,0.9943133f,0.998200536f,0.999430835f,0.999819994f,0.999943078f,-0.258101642f,-0.967739344f,0.904607713f,-0.147529408f,0.98326844f,-0.958617806f,-0.35058254f,0.467133373f,0.819648027f,0.941740453f,0.981452644f,0.994122326f,0.998140097f,0.999411702f,0.999813974f,0.99994117f,0.673507154f,-0.953049958f,0.727197766f,0.0297536626f,0.996542096f,-0.941101313f,-0.380018055f,0.451337039f,0.813878477f,0.939834237f,0.980841517f,0.993928254f,0.998078644f,0.999392271f,0.999807835f,0.999939203f,0.985896587f,-0.644838572f,0.47767204f,0.206098318f,0.999858618f,-0.920609534f,-0.409073591f,0.435397953f,0.808027506f,0.937898219f,0.980220556f,0.993731022f,0.998016179f,0.999372482f,0.999801576f,0.999937236f};
__device__ const float ROPE_SIN64[1024] = {0.0f,0.0f,0.0f,0.0f,0.0f,0.0f,0.0f,0.0f,0.0f,0.0f,0.0f,0.0f,0.0f,0.0f,0.0f,0.0f,0.841470957f,0.533168435f,0.310983598f,0.176892191f,0.099833414f,0.0562044978f,0.0316175073f,0.0177818574f,0.00999983307f,0.00562338345f,0.00316227227f,0.0017782785f,0.000999999815f,0.000562341302f,0.000316227757f,0.00017782794f,0.909297407f,0.902130723f,0.591127098f,0.348205268f,0.198669329f,0.112231314f,0.0632033944f,0.0355580896f,0.0199986659f,0.011246589f,0.00632451335f,0.00355655141f,0.0019999987f,0.00112468237f,0.000632455514f,0.00035565588f,0.141120002f,0.993253171f,0.812648892f,0.50853616f,0.295520216f,0.167903304f,0.0947260931f,0.0533230789f,0.029995501f,0.0168694388f,0.00948669109f,0.00533481315f,0.0029999956f,0.00168702321f,0.000948683184f,0.000533483806f,-0.756802499f,0.778471768f,0.953580737f,0.652827978f,0.389418334f,0.223044485f,0.126154065f,0.0710712075f,0.0399893336f,0.0224917568f,0.0126487734f,0.00711305765f,0.00399998948f,0.00224936334f,0.00126491068f,0.000711311703f,-0.958924294f,0.323935211f,0.999946535f,0.776529968f,0.47942555f,0.277480543f,0.157455891f,0.0887968615f,0.0499791689f,0.0281133614f,0.0158107299f,0.00889127981f,0.0049999794f,0.0028117029f,0.00158113812f,0.000889139599f,-0.279415488f,-0.230367482f,0.947148144f,0.875740588f,0.564642489f,0.331039339f,0.188600287f,0.106494434f,0.0599640049f,0.0337340795f,0.0189725272f,0.0106694736f,0.0059999642f,0.00337404152f,0.00189736544f,0.0010669675f,0.656986594f,-0.713721156f,0.800421655f,0.947330713f,0.64421767f,0.383551568f,0.219556093f,0.124158338f,0.0699428469f,0.0393537283f,0.0221341364f,0.0124476347f,0.00699994294f,0.00393637922f,0.00221359264f,0.00124479528f,0.989358246f,-0.977261722f,0.574317753f,0.989042461f,0.717356086f,0.434851229f,0.250292361f,0.141782969f,0.0799146965f,0.0449721329f,0.0252955221f,0.0142257558f,0.0079999147f,0.00449871551f,0.0025298195f,0.00142262306f,0.412118495f,-0.939823508f,0.29125911f,0.999560297f,0.783326924f,0.484776139f,0.280778348f,0.159362778f,0.0898785517f,0.0505891144f,0.0284566563f,0.0160038322f,0.00899987854f,0.00506105041f,0.00284604612f,0.00160045084f,-0.54402113f,-0.612936735f,-0.0206835307f,0.97855252f,0.841470957f,0.533168435f,0.310983598f,0.176892191f,0.099833414f,0.0562044978f,0.0316175073f,0.0177818574f,0.00999983307f,0.00562338345f,0.00316227227f,0.0017782785f,-0.999990225f,-0.0972766578f,-0.330575019f,0.926681578f,0.891207337f,0.579875171f,0.340877861f,0.194365665f,0.1097783f,0.0618181042f,0.0347780399f,0.0195598267f,0.0109997783f,0.00618571509f,0.00347849843f,0.00195610616f,-0.536572933f,0.44834289f,-0.607683539f,0.845583558f,0.932039082f,0.624748647f,0.370431304f,0.211777672f,0.119712204f,0.0674297586f,0.037938226f,0.0213377327f,0.0119997123f,0.00674804486f,0.00379472412f,0.00213393359f,0.420167029f,0.855880976f,-0.824528456f,0.737816215f,0.963558197f,0.667647004f,0.399614334f,0.229122713f,0.129634142f,0.0730392784f,0.0410980321f,0.0231155735f,0.0129996343f,0.00731037231f,0.00411094958f,0.00231176126f,0.990607381f,0.999823332f,-0.959605336f,0.606778562f,0.985449731f,0.708434701f,0.428397804f,0.246395305f,0.139543116f,0.078646481f,0.0442574248f,0.0248933397f,0.0139995422f,0.00787269697f,0.00442717411f,0.00248958869f,0.650287867f,0.835838318f,-0.999518692f,0.456603318f,0.997494996f,0.746982634f,0.456752867f,0.263589978f,0.149438128f,0.0842512026f,0.0474163778f,0.0266710278f,0.0149994371f,0.00843502022f,0.00474339863f,0.00266741589f,-0.287903309f,0.41443032f,-0.940310359f,0.292027056f,0.999573588f,0.783169091f,0.484651268f,0.280701309f,0.159318209f,0.0898532644f,0.0505748577f,0.028448632f,0.0159993172f,0.00899733976f,0.00505962269f,0.00284524332f,-0.961397469f,-0.134614661f,-0.78785193f,0.118240394f,0.991664827f,0.81687957f,0.512064993f,0.29772386f,0.169182345f,0.09545248f,0.053732831f,0.0302261449f,0.0169991814f,0.00955965649f,0.00537584629f,0.00302307028f,-0.750987232f,-0.642200768f,-0.557262719f,-0.0592755191f,0.973847628f,0.8480075f,0.538966775f,0.314652264f,0.179029569f,0.101048678f,0.0568902642f,0.0320035629f,0.0179990288f,0.0101219714f,0.00569206895f,0.00320089748f,0.149877205f,-0.952000737f,-0.271410018f,-0.234921902f,0.946300089f,0.876454532f,0.565329552f,0.331481189f,0.188858896f,0.10664168f,0.060047131f,0.0337808803f,0.0189988576f,0.0106842816f,0.00600829162f,0.00337872445f,0.912945271f,-0.968601882f,0.0413582139f,-0.403158963f,0.909297407f,0.902130723f,0.591127098f,0.348205268f,0.198669329f,0.112231314f,0.0632033944f,0.0355580896f,0.0199986659f,0.011246589f,0.00632451335f,0.00355655141f,0.836655617f,-0.686891258f,0.350024998f,-0.558680594f,0.863209367f,0.924954832f,0.616333604f,0.364819258f,0.208459899f,0.117817394f,0.0663590282f,0.0373351872f,0.0209984574f,0.0118088936f,0.00664073415f,0.00373437814f,-0.00885130931f,-0.193630621f,0.623979986f,-0.696581662f,0.808496416f,0.944854796f,0.640923738f,0.381317884f,0.218229622f,0.123399749f,0.0695139989f,0.0391121693f,0.0219982248f,0.0123711936f,0.00695695495f,0.00391220488f,-0.846220434f,0.359264702f,0.836055219f,-0.812512934f,0.745705187f,0.961767614f,0.664873064f,0.397695929f,0.227977529f,0.128978208f,0.0726682767f,0.0408890247f,0.0229979716f,0.0129334899f,0.00727317436f,0.00409003114f,-0.905578375f,0.801513016f,0.965219319f,-0.902817845f,0.6754632f,0.97563988f,0.688157558f,0.413948208f,0.237702623f,0.134552568f,0.0758218244f,0.0426657498f,0.0239976961f,0.0134957824f,0.0075893933f,0.00426785741f,-0.132351756f,0.996909976f,0.998663187f,-0.964648366f,0.598472118f,0.986427724f,0.710753918f,0.430069596f,0.247403964f,0.140122697f,0.0789746195f,0.0444423407f,0.0249973964f,0.0140580703f,0.00790561177f,0.00444568368f,0.76255846f,0.885276794f,0.933070183f,-0.996054351f,0.51550138f,0.994096994f,0.732639611f,0.446054965f,0.257080555f,0.145688385f,0.0821266174f,0.0462187938f,0.0259970706f,0.0146203535f,0.00822182931f,0.00462350994f,0.956375957f,0.500994503f,0.77494514f,-0.996045172f,0.427379876f,0.99862349f,0.753792763f,0.46189931f,0.266731441f,0.151249468f,0.0852777958f,0.0479950979f,0.0269967187f,0.015182632f,0.00853804592f,0.00480133574f,0.270905793f,-0.0375849828f,0.539969206f,-0.964621246f,0.334988147f,0.999992907f,0.774192154f,0.477597594f,0.276355654f,0.156805769f,0.0884281248f,0.049771253f,0.0279963408f,0.0157449059f,0.0088542616f,0.00497916155f,-0.663633883f,-0.564588964f,0.251444817f,-0.902773619f,0.239249334f,0.998200953f,0.793817401f,0.49314484f,0.28595221f,0.162357107f,0.0915775672f,0.0515472479f,0.0289959349f,0.0163071752f,0.00917047635f,0.00515698735f,-0.988031626f,-0.917709827f,-0.0620152019f,-0.812452912f,0.141120002f,0.993253171f,0.812648892f,0.50853616f,0.295520216f,0.167903304f,0.0947260931f,0.0533230789f,0.029995501f,0.0168694388f,0.00948669109f,0.00533481315f,-0.404037654f,-0.988192797f,-0.369325221f,-0.696507812f,0.0415806621f,0.985165298f,0.830667794f,0.523766637f,0.305058628f,0.173444211f,0.0978736728f,0.055098746f,0.0309950355f,0.0174316987f,0.00980290398f,0.00551263802f,0.551426709f,-0.754330397f,-0.640009463f,-0.55859524f,-0.0583741441f,0.973962843f,0.847856164f,0.538831532f,0.314566553f,0.17897962f,0.101020269f,0.0568742342f,0.0319945402f,0.0179939512f,0.0101191159f,0.00569046335f,0.999911845f,-0.288147956f,-0.847224295f,-0.403064787f,-0.157745689f,0.959681332f,0.864196718f,0.553725958f,0.324043036f,0.184509367f,0.10416586f,0.0586495437f,0.0329940096f,0.0185561981f,0.010435327f,0.00586828822f,0.529082716f,0.266778797f,-0.97042042f,-0.234821871f,-0.255541116f,0.942365766f,0.879673123f,0.568445385f,0.333487093f,0.190033287f,0.107310407f,0.0604246706f,0.0339934491f,0.0191184394f,0.010751537f,0.00604611309f,-0.428182662f,0.739542544f,-0.997380435f,-0.0591727868f,-0.350783229f,0.92207104f,0.894269943f,0.582984984f,0.342897803f,0.195551187f,0.110453889f,0.0621996038f,0.034992855f,0.0196806751f,0.0110677462f,0.00622393796f,-0.991778851f,0.984540641f,-0.925430834f,0.118342586f,-0.44252044f,0.89886117f,0.907972574f,0.597340286f,0.352274239f,0.201062918f,0.113596253f,0.0639743432f,0.0359922238f,0.0202429052f,0.0113839535f,0.00640176237f,-0.643538117f,0.926318169f,-0.761706769f,0.292125493f,-0.529836118f,0.872809649f,0.920767248f,0.611506641f,0.361615419f,0.206568286f,0.116737492f,0.0657488778f,0.036991559f,0.0208051279f,0.0117001608f,0.0065795863f,0.296368569f,0.582806587f,-0.522444665f,0.456694871f,-0.611857891f,0.84399873f,0.932641327f,0.625479698f,0.370920479f,0.212067112f,0.119877562f,0.0675232038f,0.0379908569f,0.021367345f,0.0120163662f,0.00675741024f,0.963795364f,0.0598011911f,-0.231372029f,0.60686034f,-0.687766135f,0.81251961f,0.943582773f,0.639254928f,0.380188406f,0.217559248f,0.123016424f,0.0692973137f,0.0389901139f,0.0219295528f,0.0123325698f,0.00693523418f,0.745113134f,-0.481621891f,0.0826456547f,0.737885714f,-0.756802499f,0.778471768f,0.953580737f,0.652827978f,0.389418334f,0.223044485f,0.126154065f,0.0710712075f,0.0399893336f,0.0224917568f,0.0126487734f,0.00711305765f,-0.158622667f,-0.874714196f,0.388467401f,0.845638514f,-0.818277121f,0.74196279f,0.962625206f,0.666194677f,0.39860934f,0.228522688f,0.129290447f,0.0728448778f,0.0409885123f,0.0230539516f,0.0129649751f,0.00729088113f,-0.916521549f,-0.998410463f,0.655765057f,0.926720262f,-0.871575773f,0.703108132f,0.970707119f,0.679350615f,0.407760441f,0.233993649f,0.132425532f,0.0746183172f,0.0419876538f,0.0236161407f,0.0132811759f,0.00746870413f,-0.831774771f,-0.814614534f,0.858030856f,0.97857368f,-0.916165948f,0.662030637f,0.977818429f,0.692291796f,0.416870803f,0.23945722f,0.135559291f,0.0763915181f,0.0429867506f,0.0241783205f,0.0135973748f,0.00764652714f,0.0177019257f,-0.379932135f,0.975206256f,0.999563336f,-0.951602101f,0.618860185f,0.983951986f,0.70501405f,0.425939471f,0.24491322f,0.138691694f,0.0781644806f,0.0439858027f,0.0247404929f,0.0139135728f,0.00782434922f,0.850903511f,0.171762422f,0.995670974f,0.989027262f,-0.977530122f,0.57373327f,0.989101648f,0.717513323f,0.434965521f,0.250361472f,0.141822711f,0.0799371973f,0.0449848138f,0.0253026597f,0.0142297689f,0.00800217222f,0.901788354f,0.670557261f,0.917395532f,0.947297752f,-0.993691027f,0.526792467f,0.993262351f,0.72978574f,0.44394812f,0.255801797f,0.144952312f,0.0817096531f,0.0459837802f,0.0258648153f,0.0145459641f,0.0081799943f,0.123573124f,0.962832689f,0.748142481f,0.875690877f,-0.999923229f,0.47818628f,0.996429801f,0.741827369f,0.452886283f,0.261234045f,0.148080453f,0.0834818631f,0.0469826981f,0.0264269654f,0.0148621574f,0.00835781638f,-0.768254638f,0.958573222f,0.504696608f,0.776465118f,-0.99616462f,0.42806834f,0.99860096f,0.753634453f,0.461779177f,0.266658038f,0.151207134f,0.0852537975f,0.0479815714f,0.0269891061f,0.0151783498f,0.00853563752f,-0.953752637f,0.659090638f,0.211200237f,0.652750015f,-0.982452631f,0.376597077f,0.999773562f,0.765203178f,0.470625877f,0.272073597f,0.15433228f,0.087025471f,0.0489803925f,0.0275512375f,0.0154945403f,0.00871345866f,-0.262374848f,0.156620145f,-0.103240743f,0.508447528f,-0.958924294f,0.323935211f,0.999946535f,0.776529968f,0.47942555f,0.277480543f,0.157455891f,0.0887968615f,0.0499791689f,0.0281133614f,0.0158107299f,0.00889127981f,0.670229197f,-0.39408651f,-0.407443404f,0.348108798f,-0.925814688f,0.270249248f,0.99911958f,0.787611187f,0.48817724f,0.282878697f,0.160577938f,0.0905679762f,0.0509778932f,0.0286754761f,0.0161269177f,0.00906910095f,0.986627579f,-0.823421657f,-0.671240151f,0.176790893f,-0.88345468f,0.215708897f,0.997293591f,0.798443377f,0.496880144f,0.28826794f,0.163698375f,0.0923388004f,0.051976569f,0.0292375814f,0.0164431036f,0.00924692117f,0.395925164f,-0.999157965f,-0.868470371f,-0.00010291244f,-0.832267463f,0.160486609f,0.994470417f,0.809023023f,0.505533338f,0.293648034f,0.166817173f,0.0941093415f,0.0529751889f,0.0297996774f,0.0167592876f,0.00942474138f,-0.558789074f,-0.867171824f,-0.979574859f,-0.176993474f,-0.772764504f,0.104756944f,0.990652859f,0.819346905f,0.514136016f,0.29901886f,0.169934288f,0.0958795771f,0.0539737605f,0.0303617641f,0.0170754697f,0.00960256159f,-0.999755144f,-0.468112558f,-0.993535459f,-0.348301739f,-0.705540299f,0.0486961007f,0.985844731f,0.829411626f,0.522687256f,0.304380238f,0.173049718f,0.0976495072f,0.0549722761f,0.0309238415f,0.01739165f,0.00978038087f,-0.521551013f,0.0751168504f,-0.908967733f,-0.508624732f,-0.631266654f,-0.0075186966f,0.980050862f,0.839214146f,0.531186223f,0.30973199f,0.17616342f,0.0994191319f,0.0559707358f,0.0314859077f,0.0177078284f,0.00995820016f,0.436164767f,0.595211625f,-0.734258175f,-0.652905941f,-0.550685525f,-0.063709721f,0.973276973f,0.848751247f,0.539632022f,0.315073937f,0.179275364f,0.101188444f,0.0569691397f,0.0320479684f,0.0180240069f,0.0101360194f,0.992872655f,0.931992114f,-0.486732632f,-0.776594818f,-0.464602172f,-0.119699337f,0.965529919f,0.858019948f,0.548023939f,0.32040593f,0.182385504f,0.102957435f,0.0579674877f,0.0326100141f,0.0183401816f,0.0103138378f,0.636738002f,0.981735945f,-0.190938085f,-0.875790238f,-0.373876661f,-0.175310522f,0.956817389f,0.867017329f,0.55636102f,0.325727791f,0.185493827f,0.104726106f,0.0589657761f,0.0331720524f,0.0186563563f,0.0104916561f,-0.304810613f,0.729123056f,0.123791665f,-0.947363675f,-0.279415488f,-0.230367482f,0.947148144f,0.875740588f,0.564642489f,0.331039339f,0.188600287f,0.106494434f,0.0599640049f,0.0337340795f,0.0189725272f,0.0106694736f,-0.966117799f,0.251953512f,0.426245064f,-0.98905766f,-0.182162508f,-0.284696132f,0.936531842f,0.884186864f,0.572867453f,0.336340427f,0.191704869f,0.108262435f,0.0609621778f,0.0342960954f,0.0192886982f,0.0108472919f,-0.739180684f,-0.302813113f,0.68642801f,-0.999557257f,-0.0830894038f,-0.338124752f,0.924979091f,0.892353535f,0.581035137f,0.341630876f,0.194807529f,0.110030092f,0.0619602874f,0.0348581001f,0.0196048655f,0.0110251093f,0.167355701f,-0.764318824f,0.878538251f,-0.978531301f,0.0168139003f,-0.390484393f,0.912501395f,0.900238097f,0.589144766f,0.346910506f,0.197908238f,0.1117974f,0.0629583374f,0.0354200937f,0.0199210308f,0.0112029258f};


__device__ __forceinline__ unsigned cvt_pk_bf16(float lo, float hi) { unsigned r; asm volatile("v_cvt_pk_bf16_f32 %0, %1, %2" : "=v"(r) : "v"(lo), "v"(hi)); return r; }
__device__ __forceinline__ float bf_lo(unsigned u) { return __uint_as_float(u << 16); }
__device__ __forceinline__ float bf_hi(unsigned u) { return __uint_as_float(u & 0xffff0000u); }
__device__ __forceinline__ float bf1(bf16_t u) { return __uint_as_float((unsigned)u << 16); }
__device__ __forceinline__ float fast_exp2(float x) { return __builtin_amdgcn_exp2f(x); }
__device__ __forceinline__ float wave_sum(float v) {
#pragma unroll
    for (int o = 1; o < 64; o <<= 1) v += __shfl_xor(v, o);
    return v;
}
#define LDS_WAIT() asm volatile("s_waitcnt lgkmcnt(0)" ::: "memory")

#define XB_TMO      128
#define XB_XCNT(j)  (256  + 64 * (j))
#define XB_XSUB(j)  (1280 + 64 * (j))
#define XB_XGEN(j)  (2304 + 64 * (j))
#define XB_TOP      3328
#define XB_TOPGEN   3392
#define XCD_BAR_WORDS 3456
#define XB_SPIN_CAP (1u << 18)
__device__ __forceinline__ unsigned xb_ld(unsigned* p)              { return __hip_atomic_load(p, __ATOMIC_RELAXED, __HIP_MEMORY_SCOPE_AGENT); }
__device__ __forceinline__ unsigned xb_add(unsigned* p, unsigned v) { return __hip_atomic_fetch_add(p, v, __ATOMIC_RELAXED, __HIP_MEMORY_SCOPE_AGENT); }
__device__ __forceinline__ unsigned xb_xcc_id() { return (unsigned)__builtin_amdgcn_s_getreg((3 << 11) | 20) & 0xFu; }
#define XB_SPIN(cond, bar) do { unsigned _sp = 0; while (cond) { __builtin_amdgcn_s_sleep(1); \
    if ((++_sp & 255u) == 0u) { if (xb_ld(&(bar)[XB_TMO])) break; if (_sp > XB_SPIN_CAP) { atomicAdd(&(bar)[XB_TMO], 1u); break; } } } } while (0)
struct XcdBarrier { unsigned* bar; unsigned x; volatile LAS unsigned* st; };
__device__ __forceinline__ XcdBarrier xcd_barrier_post(unsigned* bar, volatile LAS unsigned* st) {
    XcdBarrier b; b.bar = bar; b.x = xb_xcc_id(); b.st = st;
    if (threadIdx.x == 0) (void)xb_add(&bar[XB_XCNT(b.x)], 1u);
    return b;
}
__device__ __forceinline__ void xcd_barrier_complete(unsigned* bar, unsigned x, unsigned& nloc, unsigned& nx) {
    const unsigned G = gridDim.x * gridDim.y * gridDim.z;
    unsigned sum, cnt, mine, sp = 0u;
    for (;;) {
        sum = 0u; cnt = 0u; mine = 0u;
#pragma unroll
        for (unsigned j = 0; j < 16; ++j) { const unsigned c = xb_ld(&bar[XB_XCNT(j)]); sum += c; cnt += (c > 0u) ? 1u : 0u; mine = (j == x) ? c : mine; }
        if (sum == G) break;
        __builtin_amdgcn_s_sleep(1);
        if ((++sp & 255u) == 0u) { if (xb_ld(&bar[XB_TMO])) break; if (sp > XB_SPIN_CAP) { atomicAdd(&bar[XB_TMO], 1u); break; } }
    }
    nloc = mine > 0u ? mine : 1u; nx = cnt > 0u ? cnt : 1u;
}
__device__ __forceinline__ void xcd_barrier(const XcdBarrier& b) {
    asm volatile("s_waitcnt vmcnt(0)" ::: "memory");
    __syncthreads();
    if (threadIdx.x == 0) {
        unsigned* bar = b.bar;
        __builtin_amdgcn_s_waitcnt(0);
        unsigned nloc = b.st[0], nx = b.st[1];
        if (nloc == 0u) { xcd_barrier_complete(bar, b.x, nloc, nx); b.st[0] = nloc; b.st[1] = nx; }
        const unsigned old = xb_add(&bar[XB_XSUB(b.x)], 1u);
        const unsigned gen = old / nloc;
        if (old + 1u == (gen + 1u) * nloc) {
            __builtin_amdgcn_fence(__ATOMIC_RELEASE, "agent");
            asm volatile("s_waitcnt vmcnt(0)" ::: "memory");
            const unsigned og = xb_add(&bar[XB_TOP], 1u);
            const unsigned tg = og / nx;
            if (og + 1u == (tg + 1u) * nx) xb_add(&bar[XB_TOPGEN], 1u);
            else XB_SPIN(xb_ld(&bar[XB_TOPGEN]) == tg, bar);
            __builtin_amdgcn_fence(__ATOMIC_ACQUIRE, "agent");
            xb_add(&bar[XB_XGEN(b.x)], 1u);
            asm volatile("s_waitcnt vmcnt(0)" ::: "memory");
        } else {
            XB_SPIN(xb_ld(&bar[XB_XGEN(b.x)]) == gen, bar);
            __builtin_amdgcn_fence(__ATOMIC_ACQUIRE, "agent");
            asm volatile("s_waitcnt vmcnt(0)" ::: "memory");
        }
    }
    __syncthreads();
}

namespace pg8 {
constexpr int BM = 256, BK = 64, HALF = 128, HTB = HALF * BK * 2, STAGE_BYTES = 8 * HTB, NXCD = 8, WGM = 8;
__host__ __device__ __forceinline__ int lds_byte(int r, int c) { const int st = (r >> 4) * 2 + (c >> 5), rr = r & 15, cc = c & 31, ob = rr * 64 + cc * 2; return st * 1024 + (ob ^ (((ob >> 9) & 1) << 5)); }
__host__ __device__ __forceinline__ void stage_rc(int b, int& R, int& C) { const int st = b / 1024, sb = b % 1024, swz = sb ^ (((sb >> 9) & 1) << 5); R = (st >> 1) * 16 + swz / 64; C = (st & 1) * 32 + (swz % 64) / 2; }
__host__ __device__ __forceinline__ int perm32(int rho) { const int n = rho >> 4, i = rho & 15; return 8 * (i >> 2) + 4 * n + (i & 3); }
struct Unit { int pm, pn; };
struct Prob {
    const char* A; const char* B; int nt, lda, ldb; size_t hstepB;
    size_t a_pm, a_pnhi; int a_sh;
    size_t b_pnlo, b_pnhi; int b_mask, b_sh;
    __device__ __forceinline__ const char* abase(const Unit& u) const { return A + (size_t)u.pm * a_pm + (size_t)(u.pn >> a_sh) * a_pnhi; }
    __device__ __forceinline__ const char* bbase(const Unit& u) const { return B + (size_t)(u.pn & b_mask) * b_pnlo + (size_t)(u.pn >> b_sh) * b_pnhi; }
};
__device__ __forceinline__ Prob plain_prob(const bf16_t* A, int lda, const bf16_t* Bt, int K) {
    Prob p; p.A = (const char*)A; p.B = (const char*)Bt; p.nt = K / BK; p.lda = lda; p.ldb = K; p.hstepB = (size_t)HALF * K * 2;
    p.a_pm = (size_t)BM * lda * 2; p.a_pnhi = 0; p.a_sh = 0; p.b_pnlo = (size_t)BM * K * 2; p.b_pnhi = 0; p.b_mask = ~0; p.b_sh = 0; return p;
}
struct StaticOrder {
    int nM, nN, nwg, G, c;
    __host__ __device__ void init(int nM_, int nN_, int G_, int c_) { nM = nM_; nN = nN_; nwg = nM * nN; G = G_; c = c_; }
    __host__ __device__ bool next(int i, Unit& u) const {
        const long L = (long)i * G + c; if (L >= nwg) return false;
        int wgid = (int)L; { const int q = nwg / NXCD, r = nwg % NXCD, xcd = wgid % NXCD, off = wgid / NXCD; wgid = (xcd < r ? xcd * (q + 1) : r * (q + 1) + (xcd - r) * q) + off; }
        const int nig = WGM * nN, gid = wgid / nig, fm = gid * WGM, gsz = (nM - fm) < WGM ? (nM - fm) : WGM;
        u.pm = fm + ((wgid % nig) % gsz); u.pn = (wgid % nig) / gsz; return true;
    }
    __device__ __forceinline__ void a_ready(const Unit&) const {}
    __device__ __forceinline__ void done(const Unit&) const {}
};
template <class Epi, class Prob, class Sched, bool ALIGN_EPI = false, bool SP2 = false>
__device__ __forceinline__ void gemm_phase(PG8_LAS unsigned char* lds, const Prob g, const Sched& S, const Epi& E) {
    int tid_raw = threadIdx.x; asm volatile("" : "+v"(tid_raw));
    const int tid = tid_raw, wid = __builtin_amdgcn_readfirstlane(tid >> 6), lane = tid & 63, wr = wid >> 2, wc = wid & 3, fr = lane & 15, fq = lane >> 4;
    const int nt = g.nt;
    unsigned voffA[2], voffB[2];
#pragma unroll
    for (int i = 0; i < 2; ++i) { int R, C; stage_rc(tid * 16 + i * 8192, R, C); const int Rb = Epi::brow(R);
        voffA[i] = (unsigned)(R * g.lda + C) * 2u; voffB[i] = (unsigned)(Rb * g.ldb + C) * 2u; }
    const size_t kstep = (size_t)(BK * 2);
    const size_t hstepA = (size_t)HALF * g.lda * 2, hstepB = g.hstepB;
    const unsigned ldsw = (unsigned)wid * 1024u;
    const int aoff = lds_byte(wr * 64 + fr, fq * 8), boff = lds_byte(wc * 32 + fr, fq * 8);
#define PG8_SA(b, h) (((b) * 2 + (h)) * HTB)
#define PG8_SB(b, h) ((4 + (b) * 2 + (h)) * HTB)
#define PG8_STAGE(bufoff, gbase, voff) do { _Pragma("unroll") for (int _i = 0; _i < 2; ++_i) \
        __builtin_amdgcn_global_load_lds((const unsigned*)((const char*)(gbase) + (voff)[_i]), (PG8_LAS unsigned*)(lds + (bufoff) + ldsw + _i * 8192), 16, 0, 0); } while (0)
#define PG8_LDA(dst, b, h) do { _Pragma("unroll") for (int m = 0; m < 4; ++m) _Pragma("unroll") for (int k = 0; k < 2; ++k) dst[m][k] = *(const PG8_LAS bf16x8*)(lds + PG8_SA(b, h) + aoff + m * 2048 + k * 1024); } while (0)
#define PG8_LDB(dst, b, h) do { _Pragma("unroll") for (int n = 0; n < 2; ++n) _Pragma("unroll") for (int k = 0; k < 2; ++k) dst[n][k] = *(const PG8_LAS bf16x8*)(lds + PG8_SB(b, h) + boff + n * 2048 + k * 1024); } while (0)
#define PG8_MMA(ai, bj, At, Bt) do { __builtin_amdgcn_s_setprio(1); _Pragma("unroll") for (int m = 0; m < 4; ++m) _Pragma("unroll") for (int n = 0; n < 2; ++n) _Pragma("unroll") for (int k = 0; k < 2; ++k) \
        acc[ai][bj][m][n] = __builtin_amdgcn_mfma_f32_16x16x32_bf16(Bt[n][k], At[m][k], acc[ai][bj][m][n], 0, 0, 0); __builtin_amdgcn_s_setprio(0); } while (0)
#define PG8_WAIT_V(n) asm volatile("s_waitcnt vmcnt(" #n ")" ::: "memory")
#define PG8_WAIT_L(n) asm volatile("s_waitcnt lgkmcnt(" #n ")" ::: "memory")
#define PG8_BAR __builtin_amdgcn_s_barrier()
#define PG8_SCHED __builtin_amdgcn_sched_barrier(0)
    Unit cur, nxt; int ui = 0;
    if (!S.next(0, cur)) return;
    f32x4 acc[2][2][4][2];
#pragma unroll
    for (int a = 0; a < 2; ++a)
#pragma unroll
        for (int b = 0; b < 2; ++b)
#pragma unroll
            for (int m = 0; m < 4; ++m)
#pragma unroll
                for (int n = 0; n < 2; ++n) acc[a][b][m][n] = (f32x4){0.f, 0.f, 0.f, 0.f};
    bf16x8 At[4][2], B0[2][2], B1[2][2];
    const char* cA = g.abase(cur); const char* cB = g.bbase(cur);
    S.a_ready(cur);
    if constexpr (SP2) {
        PG8_STAGE(PG8_SB(0, 0), cB, voffB); PG8_STAGE(PG8_SB(0, 1), cB + hstepB, voffB); PG8_STAGE(PG8_SA(0, 0), cA, voffA); PG8_STAGE(PG8_SA(0, 1), cA + hstepA, voffA);
        if (wr == 1) PG8_BAR;
        PG8_WAIT_V(2); PG8_BAR;
        PG8_STAGE(PG8_SB(1, 0), cB + kstep, voffB); PG8_STAGE(PG8_SA(1, 0), cA + kstep, voffA); PG8_STAGE(PG8_SB(1, 1), cB + hstepB + kstep, voffB);
        PG8_WAIT_V(6); PG8_BAR;
    } else {
        PG8_STAGE(PG8_SB(0, 0), cB, voffB); PG8_STAGE(PG8_SA(0, 0), cA, voffA); PG8_STAGE(PG8_SB(0, 1), cB + hstepB, voffB); PG8_STAGE(PG8_SA(0, 1), cA + hstepA, voffA);
        if (wr == 1) PG8_BAR;
        PG8_WAIT_V(4); PG8_BAR;
        PG8_STAGE(PG8_SB(1, 0), cB + kstep, voffB); PG8_STAGE(PG8_SA(1, 0), cA + kstep, voffA); PG8_STAGE(PG8_SB(1, 1), cB + hstepB + kstep, voffB);
        PG8_WAIT_V(6); PG8_BAR;
    }
    for (;;) {
        const bool has_next = S.next(ui + 1, nxt);
        const char* nA = has_next ? g.abase(nxt) : cA; const char* nB = has_next ? g.bbase(nxt) : cB;
        for (int t = 0; t < nt; t += 2) {
            const bool last = (t == nt - 2);
            const char* a1 = cA + (size_t)(t + 1) * kstep;
            const char* a2 = last ? nA : cA + (size_t)(t + 2) * kstep; const char* b2 = last ? nB : cB + (size_t)(t + 2) * kstep;
            const char* a3 = a2 + kstep; const char* b3 = b2 + kstep;
            if (last && has_next) S.a_ready(nxt);
            if constexpr (SP2) {
            PG8_LDB(B0, 0, 0); PG8_LDB(B1, 0, 1); PG8_SCHED; PG8_LDA(At, 0, 0); PG8_STAGE(PG8_SA(1, 1), a1 + hstepA, voffA);
            PG8_WAIT_V(8); PG8_WAIT_L(0); PG8_BAR; PG8_MMA(0, 0, At, B0); PG8_MMA(0, 1, At, B1); PG8_BAR; PG8_SCHED;
            PG8_LDA(At, 0, 1); PG8_STAGE(PG8_SB(0, 0), b2, voffB); PG8_STAGE(PG8_SB(0, 1), b2 + hstepB, voffB); PG8_STAGE(PG8_SA(0, 0), a2, voffA);
            PG8_WAIT_V(8); PG8_WAIT_L(0); PG8_BAR; PG8_MMA(1, 0, At, B0); PG8_MMA(1, 1, At, B1); PG8_BAR; PG8_SCHED;
            PG8_LDB(B0, 1, 0); PG8_LDB(B1, 1, 1); PG8_SCHED; PG8_LDA(At, 1, 0); PG8_STAGE(PG8_SA(0, 1), a2 + hstepA, voffA);
            PG8_WAIT_V(8); PG8_WAIT_L(0); PG8_BAR; PG8_MMA(0, 0, At, B0); PG8_MMA(0, 1, At, B1); PG8_BAR; PG8_SCHED;
            PG8_LDA(At, 1, 1); PG8_STAGE(PG8_SB(1, 0), b3, voffB); PG8_STAGE(PG8_SB(1, 1), b3 + hstepB, voffB); PG8_STAGE(PG8_SA(1, 0), a3, voffA);
            PG8_WAIT_V(8); PG8_WAIT_L(0); PG8_BAR; PG8_MMA(1, 0, At, B0); PG8_MMA(1, 1, At, B1); PG8_BAR; PG8_SCHED;
            } else {
            PG8_LDB(B0, 0, 0); PG8_SCHED; PG8_LDA(At, 0, 0); PG8_STAGE(PG8_SA(1, 1), a1 + hstepA, voffA);
            PG8_WAIT_L(8); PG8_BAR; PG8_WAIT_L(0); PG8_MMA(0, 0, At, B0); PG8_BAR; PG8_SCHED;
            PG8_LDB(B1, 0, 1); PG8_STAGE(PG8_SB(0, 0), b2, voffB);
            PG8_BAR; PG8_WAIT_L(0); PG8_MMA(0, 1, At, B1); PG8_BAR;
            PG8_LDA(At, 0, 1); PG8_STAGE(PG8_SA(0, 0), a2, voffA);
            PG8_BAR; PG8_WAIT_L(0); PG8_MMA(1, 0, At, B0); PG8_BAR; PG8_SCHED;
            PG8_STAGE(PG8_SB(0, 1), b2 + hstepB, voffB);
            PG8_WAIT_V(6); PG8_BAR; PG8_MMA(1, 1, At, B1); PG8_BAR;
            PG8_LDB(B0, 1, 0); PG8_SCHED; PG8_LDA(At, 1, 0); PG8_STAGE(PG8_SA(0, 1), a2 + hstepA, voffA);
            PG8_WAIT_L(8); PG8_BAR; PG8_WAIT_L(0); PG8_MMA(0, 0, At, B0); PG8_BAR; PG8_SCHED;
            PG8_LDB(B1, 1, 1); PG8_STAGE(PG8_SB(1, 0), b3, voffB);
            PG8_BAR; PG8_WAIT_L(0); PG8_MMA(0, 1, At, B1); PG8_BAR;
            PG8_LDA(At, 1, 1); PG8_STAGE(PG8_SA(1, 0), a3, voffA);
            PG8_BAR; PG8_WAIT_L(0); PG8_MMA(1, 0, At, B0); PG8_BAR; PG8_SCHED;
            PG8_STAGE(PG8_SB(1, 1), b3 + hstepB, voffB);
            PG8_WAIT_V(6); PG8_BAR; PG8_MMA(1, 1, At, B1); PG8_BAR;
            }
        }
        if constexpr (ALIGN_EPI) { if (wr == 0) PG8_BAR; }
        if constexpr (!Epi::AFTER_DRAIN) { E(acc, cur, wr, wc, fr, fq); S.done(cur); }
        if (!has_next) break;
#pragma unroll
        for (int a = 0; a < 2; ++a)
#pragma unroll
            for (int b = 0; b < 2; ++b)
#pragma unroll
                for (int m = 0; m < 4; ++m)
#pragma unroll
                    for (int n = 0; n < 2; ++n) acc[a][b][m][n] = (f32x4){0.f, 0.f, 0.f, 0.f};
        cur = nxt; cA = nA; cB = nB; ++ui;
        if constexpr (ALIGN_EPI) { if (wr == 1) PG8_BAR; }
    }
    PG8_WAIT_V(0);
    if constexpr (!ALIGN_EPI) { if (wr == 0) PG8_BAR; }
    PG8_BAR;
    if constexpr (Epi::AFTER_DRAIN) { E.fused(acc, cur, wr, wc, fr, fq, lds, wid, lane); S.done(cur); }
#undef PG8_SA
#undef PG8_SB
#undef PG8_STAGE
#undef PG8_LDA
#undef PG8_LDB
#undef PG8_MMA
#undef PG8_WAIT_V
#undef PG8_WAIT_L
#undef PG8_BAR
#undef PG8_SCHED
}

}
using pg8::Unit;

__device__ __forceinline__ int brow_perm(int R) { return (R & ~31) + pg8::perm32(R & 31); }

template <int XOR> __device__ __forceinline__ void rope8(float (&x)[8], const float* ct, const float* st, bool plus) {
    const f32x4 c0 = *(const f32x4*)ct, c1 = *(const f32x4*)(ct + 4), s0 = *(const f32x4*)st, s1 = *(const f32x4*)(st + 4);
    const float c[8] = {c0[0], c0[1], c0[2], c0[3], c1[0], c1[1], c1[2], c1[3]}, s[8] = {s0[0], s0[1], s0[2], s0[3], s1[0], s1[1], s1[2], s1[3]};
#pragma unroll
    for (int f = 0; f < 8; ++f) { const float p = __shfl_xor(x[f], XOR); x[f] = x[f] * c[f] + (plus ? p : -p) * s[f]; }
}

struct EpiP {
    static constexpr bool AFTER_DRAIN = false;
    static __device__ __forceinline__ int brow(int R) { return brow_perm(R); }
    bf16_t* P; float* ssq_q; float* ssq_kv; const float* ssq_h; const float* bias;
    __device__ __forceinline__ void operator()(const f32x4 (&acc)[2][2][4][2], const Unit& u, int wr, int wc, int fr, int fq) const {
        asm volatile("" : "+v"(fr), "+v"(fq));
        const int pn = u.pn; const bool lat = u.pm < 64; const int rmod = lat ? (u.pm >> 3) : 8;
        f32x4 bv[2][2];
#pragma unroll
        for (int bj = 0; bj < 2; ++bj)
#pragma unroll
            for (int n = 0; n < 2; ++n) bv[bj][n] = *(const f32x4*)(bias + (size_t)rmod * BIASW + pn * 256 + bj * 128 + wc * 32 + fq * 8 + n * 4);
        float rs[2][4];
#pragma unroll
        for (int ai = 0; ai < 2; ++ai)
#pragma unroll
            for (int m = 0; m < 4; ++m) rs[ai][m] = ssq_h[u.pm * 256 + ai * 128 + wr * 64 + m * 16 + fr];
#pragma unroll
        for (int ai = 0; ai < 2; ++ai)
#pragma unroll
            for (int m = 0; m < 4; ++m) {
                const int row = u.pm * 256 + ai * 128 + wr * 64 + m * 16 + fr;
                const int grow = (u.pm * 4 + ai * 2 + wr) & 31, gcol = m * 16 + fr;
                const float rstd = __builtin_amdgcn_rsqf(rs[ai][m] * (1.f / DM) + EPS);
                float ss = 0.f;
#pragma unroll
                for (int bj = 0; bj < 2; ++bj) {
                    float x[8];
#pragma unroll
                    for (int n = 0; n < 2; ++n)
#pragma unroll
                        for (int e = 0; e < 4; ++e) x[4 * n + e] = acc[ai][bj][m][n][e] * rstd + bv[bj][n][e];
                    int mode = 0; float sc = 1.f;
                    if (pn == 1) mode = (bj == 1 && wc == 0) ? 1 : 0;
                    else if (pn == 2) { mode = 1; sc = DIFF_SC; }
                    else if (pn == 3) mode = 1;
                    else if (pn == 5) { mode = 2; sc = WIN_SC; }
                    else if (pn == 6) mode = (bj == 0) ? 2 : 0;
                    else if (pn == 7) sc = NA_SC;
                    if (!lat) mode = 0;
                    if (pn == 0 || (pn == 1 && bj == 0)) {
#pragma unroll
                        for (int f = 0; f < 8; ++f) ss += x[f] * x[f];
                    }
                    if (mode == 1) { const int pos = (fq < 2) ? grow : gcol; rope8<16>(x, ROPE_COS32 + pos * 8, ROPE_SIN32 + pos * 8, (fq & 1) != 0); }
                    else if (mode == 2) { const int pos = (wc & 1) ? gcol : grow; rope8<32>(x, ROPE_COS64 + pos * 16 + (fq & 1) * 8, ROPE_SIN64 + pos * 16 + (fq & 1) * 8, fq >= 2); }
                    u32x4 w; w.x = cvt_pk_bf16(x[0] * sc, x[1] * sc); w.y = cvt_pk_bf16(x[2] * sc, x[3] * sc); w.z = cvt_pk_bf16(x[4] * sc, x[5] * sc); w.w = cvt_pk_bf16(x[6] * sc, x[7] * sc);
                    *(u32x4*)(P + (size_t)row * PW + pn * 256 + bj * 128 + wc * 32 + fq * 8) = w;
                }
                if (pn <= 1) {
                    ss += __shfl_xor(ss, 16); ss += __shfl_xor(ss, 32);
                    if (fq == 0) unsafeAtomicAdd((pn == 0 ? ssq_q : ssq_kv) + row, ss);
                }
            }
    }
};

struct EpiUp {
    static constexpr bool AFTER_DRAIN = false;
    static __device__ __forceinline__ int brow(int R) { return brow_perm(R); }
    bf16_t* Q; const float* ssq_q; const float* ssq_kv;
    __device__ __forceinline__ void operator()(const f32x4 (&acc)[2][2][4][2], const Unit& u, int wr, int wc, int fr, int fq) const {
        asm volatile("" : "+v"(fr), "+v"(fq));
        const int pn = u.pn; const bool lat = u.pm < 64;
#pragma unroll
        for (int ai = 0; ai < 2; ++ai)
#pragma unroll
            for (int m = 0; m < 4; ++m) {
                const int row = u.pm * 256 + ai * 128 + wr * 64 + m * 16 + fr;
                const int grow = (u.pm * 4 + ai * 2 + wr) & 31, gcol = m * 16 + fr;
                const float rq = __builtin_amdgcn_rsqf(ssq_q[row] * (1.f / 256.f) + EPS) * MLA_SC;
                const float rkv = __builtin_amdgcn_rsqf(ssq_kv[row] * (1.f / 128.f) + EPS);
#pragma unroll
                for (int bj = 0; bj < 2; ++bj) {
                    const int g32 = pn * 8 + bj * 4 + wc;
                    float x[8];
#pragma unroll
                    for (int n = 0; n < 2; ++n)
#pragma unroll
                        for (int e = 0; e < 4; ++e) x[4 * n + e] = acc[ai][bj][m][n][e];
                    const float sc = g32 < 12 ? rq : (g32 < 28 ? rkv : 0.f);
                    if (g32 < 12 && (g32 % 3) == 2 && lat) { const int pos = (fq < 2) ? grow : gcol; rope8<16>(x, ROPE_COS32 + pos * 8, ROPE_SIN32 + pos * 8, (fq & 1) != 0); }
                    u32x4 w; w.x = cvt_pk_bf16(x[0] * sc, x[1] * sc); w.y = cvt_pk_bf16(x[2] * sc, x[3] * sc); w.z = cvt_pk_bf16(x[4] * sc, x[5] * sc); w.w = cvt_pk_bf16(x[6] * sc, x[7] * sc);
                    *(u32x4*)(Q + (size_t)row * QW + pn * 256 + bj * 128 + wc * 32 + fq * 8) = w;
                }
            }
    }
};

template <int ACT> struct EpiBf16 {
    static constexpr bool AFTER_DRAIN = false;
    static __device__ __forceinline__ int brow(int R) { return brow_perm(R); }
    bf16_t* O; int ldc; const float* ssq_h; const float* bias;
    __device__ __forceinline__ void operator()(const f32x4 (&acc)[2][2][4][2], const Unit& u, int wr, int wc, int fr, int fq) const {
        asm volatile("" : "+v"(fr), "+v"(fq));
        f32x4 bv[2][2];
        if (ACT == 1) { const int rmod = u.pm < 64 ? (u.pm >> 3) : 8;
#pragma unroll
            for (int bj = 0; bj < 2; ++bj)
#pragma unroll
                for (int n = 0; n < 2; ++n) bv[bj][n] = *(const f32x4*)(bias + (size_t)rmod * BIASW + u.pn * 256 + bj * 128 + wc * 32 + fq * 8 + n * 4); }
        float rs[2][4];
        if (ACT == 1) {
#pragma unroll
            for (int ai = 0; ai < 2; ++ai)
#pragma unroll
                for (int m = 0; m < 4; ++m) rs[ai][m] = ssq_h[u.pm * 256 + ai * 128 + wr * 64 + m * 16 + fr]; }
#pragma unroll
        for (int ai = 0; ai < 2; ++ai)
#pragma unroll
            for (int m = 0; m < 4; ++m) {
                const int row = u.pm * 256 + ai * 128 + wr * 64 + m * 16 + fr;
                bf16_t* rowp = O + (size_t)row * ldc + u.pn * 256 + wc * 32 + fq * 8;
                float rstd = 1.f;
                if (ACT == 1) rstd = __builtin_amdgcn_rsqf(rs[ai][m] * (1.f / DM) + EPS);
#pragma unroll
                for (int bj = 0; bj < 2; ++bj) {
                    f32x4 v0 = acc[ai][bj][m][0], v1 = acc[ai][bj][m][1];
                    if (ACT == 1) { v0 = v0 * rstd + bv[bj][0]; v1 = v1 * rstd + bv[bj][1]; }
                    if (ACT == 1) {
#pragma unroll
                        for (int e = 0; e < 4; ++e) { const float a = fmaxf(v0[e], 0.f), b = fmaxf(v1[e], 0.f); v0[e] = a * a; v1[e] = b * b; }
                    }
                    u32x4 w; w.x = cvt_pk_bf16(v0[0], v0[1]); w.y = cvt_pk_bf16(v0[2], v0[3]); w.z = cvt_pk_bf16(v1[0], v1[1]); w.w = cvt_pk_bf16(v1[2], v1[3]);
                    *(u32x4*)(rowp + bj * 128) = w;
                }
            }
    }
};

struct EpiMerge {
    static constexpr bool AFTER_DRAIN = false;
    static __device__ __forceinline__ int brow(int R) { return ((R >> 4) & 1) * 1024 + 16 * (R >> 5) + (R & 15); }
    bf16_t* Y; const bf16_t* Bcat; const float* bg; const float* ssq_h; const float* bias;
    __device__ __forceinline__ void operator()(const f32x4 (&acc)[2][2][4][2], const Unit& u, int wr, int wc, int fr, int fq) const {
        asm volatile("" : "+v"(fr), "+v"(fq));
        const int col = u.pn * 64 + wc * 16 + fq * 4; const int rmod = u.pm < 64 ? (u.pm >> 3) : 8;
        f32x4 bv[2][2];
#pragma unroll
        for (int bj = 0; bj < 2; ++bj)
#pragma unroll
            for (int n = 0; n < 2; ++n) bv[bj][n] = *(const f32x4*)(bg + (2 * bj + n) * 1024 + col) + *(const f32x4*)(bias + (size_t)rmod * BIASW + (2 * bj + n) * 1024 + col);
        float rs[2][4];
#pragma unroll
        for (int ai = 0; ai < 2; ++ai)
#pragma unroll
            for (int m = 0; m < 4; ++m) rs[ai][m] = ssq_h[u.pm * 256 + ai * 128 + wr * 64 + m * 16 + fr];
#pragma unroll
        for (int ai = 0; ai < 2; ++ai)
#pragma unroll
            for (int m = 0; m < 4; ++m) {
                const int row = u.pm * 256 + ai * 128 + wr * 64 + m * 16 + fr;
                const float rstd = __builtin_amdgcn_rsqf(rs[ai][m] * (1.f / DM) + EPS);
                f32x4 y = {0.f, 0.f, 0.f, 0.f};
#pragma unroll
                for (int bj = 0; bj < 2; ++bj)
#pragma unroll
                    for (int n = 0; n < 2; ++n) {
                        const u32x2 bw = *(const u32x2*)(Bcat + (size_t)row * 4096 + (2 * bj + n) * 1024 + col);
                        const float b[4] = {bf_lo(bw.x), bf_hi(bw.x), bf_lo(bw.y), bf_hi(bw.y)};
#pragma unroll
                        for (int e = 0; e < 4; ++e) {
                            const float g = acc[ai][bj][m][n][e] * rstd + bv[bj][n][e];
                            const float sg = __builtin_amdgcn_rcpf(1.f + fast_exp2(-g * LOG2E));
                            y[e] += sg * b[e];
                        }
                    }
                u32x2 w; w.x = cvt_pk_bf16(y[0], y[1]); w.y = cvt_pk_bf16(y[2], y[3]);
                *(u32x2*)(Y + (size_t)row * DM + col) = w;
            }
    }
};

template <bool NEXT> struct EpiRes {
    static constexpr bool AFTER_DRAIN = false;
    static __device__ __forceinline__ int brow(int R) { return brow_perm(R); }
    const float* old_lat; const float* old_ctx; float* new_lat; float* new_ctx; const float* modv;
    bf16_t* An; const float* gn; const float* scalev; float* ssq_n;
    __device__ __forceinline__ void operator()(const f32x4 (&acc)[2][2][4][2], const Unit& u, int wr, int wc, int fr, int fq) const {
        asm volatile("" : "+v"(fr), "+v"(fq));
        const bool lat = u.pm < 64; const int r = lat ? (u.pm >> 3) : 8;
        const float* ob = lat ? old_lat : old_ctx - (size_t)NLAT * DM; float* nb = lat ? new_lat : new_ctx - (size_t)NLAT * DM;
        const int col0 = u.pn * 256 + wc * 32 + fq * 8;
        f32x4 gv[2][2], Gv[2][2];
#pragma unroll
        for (int bj = 0; bj < 2; ++bj)
#pragma unroll
            for (int n = 0; n < 2; ++n) { gv[bj][n] = *(const f32x4*)(modv + (size_t)r * 6144 + col0 + bj * 128 + n * 4);
                if (NEXT) Gv[bj][n] = *(const f32x4*)(gn + col0 + bj * 128 + n * 4) * (*(const f32x4*)(scalev + (size_t)r * 6144 + col0 + bj * 128 + n * 4) + 1.f); }
#pragma unroll
        for (int ai = 0; ai < 2; ++ai)
#pragma unroll
            for (int m = 0; m < 4; ++m) {
                const int row = u.pm * 256 + ai * 128 + wr * 64 + m * 16 + fr;
                const size_t off = (size_t)row * DM + col0;
                float ss = 0.f;
#pragma unroll
                for (int bj = 0; bj < 2; ++bj) {
                    const f32x4 o0 = *(const f32x4*)(ob + off + bj * 128), o1 = *(const f32x4*)(ob + off + bj * 128 + 4);
                    const f32x4 x0 = o0 + gv[bj][0] * acc[ai][bj][m][0], x1 = o1 + gv[bj][1] * acc[ai][bj][m][1];
                    *(f32x4*)(nb + off + bj * 128) = x0; *(f32x4*)(nb + off + bj * 128 + 4) = x1;
                    if (NEXT) { ss += ((x0[0] * x0[0] + x0[1] * x0[1]) + (x0[2] * x0[2] + x0[3] * x0[3])) + ((x1[0] * x1[0] + x1[1] * x1[1]) + (x1[2] * x1[2] + x1[3] * x1[3]));
                        const f32x4 a0 = x0 * Gv[bj][0], a1 = x1 * Gv[bj][1];
                        u32x4 w; w.x = cvt_pk_bf16(a0[0], a0[1]); w.y = cvt_pk_bf16(a0[2], a0[3]); w.z = cvt_pk_bf16(a1[0], a1[1]); w.w = cvt_pk_bf16(a1[2], a1[3]);
                        *(u32x4*)(An + off + bj * 128) = w; } }
                if (NEXT) { ss += __shfl_xor(ss, 16); ss += __shfl_xor(ss, 32); if (fq == 0) unsafeAtomicAdd(ssq_n + row, ss); }
            }
    }
};

struct Args { const float* in[24]; float* out; unsigned char* ws; int ph_lo, ph_hi; };

struct Frame {
    LAS unsigned char* lds;
    int wave, G, vcu;
    Args a;
};

__device__ __forceinline__ void tr_item(const float* W, int ldw, int ks0, int cs0, bool valid, const float* gain, bf16_t* WT, int ldt, int n0, int k0, LAS float* scr, int lane) {
#pragma unroll 8
    for (int i = 0; i < 32; ++i) {
        const int kk = 2 * i + (lane >> 5), j = lane & 31; float v = 0.f;
        if (valid) { v = W[(size_t)(ks0 + kk) * ldw + cs0 + j]; if (gain) v *= gain[ks0 + kk]; }
        scr[kk * 33 + j] = v;
    }
    LDS_WAIT(); asm volatile("" ::: "memory");
    const int c = lane & 7;
#pragma unroll
    for (int j = 0; j < 4; ++j) { const int n = (lane >> 3) + 8 * j; const LAS float* s = scr + (8 * c) * 33 + n;
        u32x4 o; o.x = cvt_pk_bf16(s[0 * 33], s[1 * 33]); o.y = cvt_pk_bf16(s[2 * 33], s[3 * 33]); o.z = cvt_pk_bf16(s[4 * 33], s[5 * 33]); o.w = cvt_pk_bf16(s[6 * 33], s[7 * 33]);
        *(u32x4*)(WT + (size_t)(n0 + n) * ldt + k0 + 8 * c) = o; }
    LDS_WAIT(); asm volatile("" ::: "memory");
}
__device__ __forceinline__ void convert_weights(Frame& F, int l, size_t ws_w2, int wg0) {
    if ((int)blockIdx.x < wg0) return;
    int lane_ = threadIdx.x; asm volatile("" : "+v"(lane_)); lane_ &= 63;
    LAS float* scr = (LAS float*)(F.lds + F.wave * 16384);
    const int gw = ((int)blockIdx.x - wg0) * NWAVES + F.wave, NGW = (F.G - wg0) * NWAVES;
    constexpr int I_IN = 16 * 80, I_UP = 6 * 32, I_G = 16 * 128, I_B = 16 * 32, I_O = 16 * 32, I_1 = 16 * 128, I_2 = 64 * 32;
    constexpr int NIT = I_IN + I_UP + I_G + I_B + I_O + I_1 + I_2;
    unsigned char* ws = F.a.ws;
    for (int it = gw; it < NIT; it += NGW) {
        int r = it;
        if (r < I_IN) { const int kb = r / 80, nb = r % 80, n0 = nb * 32; const bool valid = !(n0 >= 416 && n0 < 512); const int cs0 = n0 < 416 ? n0 : n0 - 96;
            tr_item(F.a.in[I_WIN] + (size_t)l * DM * INW, INW, kb * 64, cs0, valid, nullptr, (bf16_t*)(ws + WS_WIN), DM, n0, kb * 64, scr, lane_); continue; } r -= I_IN;
        if (r < I_UP) { const int kb = r / 32, nb = r % 32, n0 = nb * 32, k0 = kb * 64;
            if (kb < 4) tr_item(F.a.in[I_WUQ] + (size_t)l * 256 * 384, 384, k0, n0, n0 < 384, F.a.in[I_QNORM] + l * 256, (bf16_t*)(ws + WS_WUP), 384, n0, k0, scr, lane_);
            else tr_item(F.a.in[I_WUKV] + (size_t)l * 128 * 512, 512, k0 - 256, n0 - 384, n0 >= 384 && n0 < 896, F.a.in[I_KVNORM] + l * 128, (bf16_t*)(ws + WS_WUP), 384, n0, k0, scr, lane_);
            continue; } r -= I_UP;
        if (r < I_G) { const int kb = r / 128, nb = r % 128; tr_item(F.a.in[I_WGATE] + (size_t)l * DM * 4096, 4096, kb * 64, nb * 32, true, nullptr, (bf16_t*)(ws + WS_WGATE), DM, nb * 32, kb * 64, scr, lane_); continue; } r -= I_G;
        if (r < I_B) { const int kb = r / 32, nb = r % 32; tr_item(F.a.in[I_WBR] + (size_t)l * DM * DM, DM, kb * 64, nb * 32, true, nullptr, (bf16_t*)(ws + WS_WBR), DM, nb * 32, kb * 64, scr, lane_); continue; } r -= I_B;
        if (r < I_O) { const int kb = r / 32, nb = r % 32; tr_item(F.a.in[I_WOUT] + (size_t)l * DM * DM, DM, kb * 64, nb * 32, true, nullptr, (bf16_t*)(ws + WS_WOUT), DM, nb * 32, kb * 64, scr, lane_); continue; } r -= I_O;
        if (r < I_1) { const int kb = r / 128, nb = r % 128; tr_item(F.a.in[I_FF1] + (size_t)l * DM * FF, FF, kb * 64, nb * 32, true, nullptr, (bf16_t*)(ws + WS_WFF1), DM, nb * 32, kb * 64, scr, lane_); continue; } r -= I_1;
        { const int kb = r / 32, nb = r % 32; tr_item(F.a.in[I_FF2] + (size_t)l * FF * DM, DM, kb * 64, nb * 32, true, nullptr, (bf16_t*)(ws + ws_w2), FF, nb * 32, kb * 64, scr, lane_); }
    }
}

template <bool SILU> __device__ __forceinline__ void gemv9_tile(Frame& F, const float* src, const float* W, int ldw, int wcol, bool valid, const float* badd, float* out, int ostride, int ocol, int kq) {
    int tid_ = threadIdx.x; asm volatile("" : "+v"(tid_)); const int lane_ = tid_ & 63;
    LAS float* sv = (LAS float*)F.lds;
    LAS f32x4* red = (LAS f32x4*)(F.lds + 9 * 256 * 4);
    for (int i = tid_; i < 9 * 256; i += 512) { const int r = i >> 8, k = kq * 256 + (i & 255);
        if (SILU) { const float x = r < 8 ? F.a.in[I_C][r * 1024 + k] : F.a.in[I_CCTX][k]; sv[i] = x / (1.f + __expf(-x)); } else sv[i] = src[(size_t)r * 6144 + k]; }
    __syncthreads();
    f32x4 a[9];
#pragma unroll
    for (int r = 0; r < 9; ++r) a[r] = (f32x4){0.f, 0.f, 0.f, 0.f};
    const float* w = W + wcol + (size_t)(kq * 256) * ldw;
    const int kbeg = F.wave * 32;
    if (valid) {
#pragma unroll 2
        for (int k0 = kbeg; k0 < kbeg + 32; k0 += 8) {
            f32x4 wv[8];
#pragma unroll
            for (int j = 0; j < 8; ++j) wv[j] = *(const f32x4*)(w + (size_t)(k0 + j) * ldw);
#pragma unroll
            for (int r = 0; r < 9; ++r) { const f32x4 s0 = *(const LAS f32x4*)(sv + r * 256 + k0), s1 = *(const LAS f32x4*)(sv + r * 256 + k0 + 4);
                a[r] += wv[0] * s0[0] + wv[1] * s0[1] + wv[2] * s0[2] + wv[3] * s0[3] + wv[4] * s1[0] + wv[5] * s1[1] + wv[6] * s1[2] + wv[7] * s1[3]; }
        }
    }
#pragma unroll
    for (int r = 0; r < 9; ++r) red[(F.wave * 9 + r) * 64 + lane_] = a[r];
    __syncthreads();
    if (F.wave == 0) {
        const f32x4 bb = (badd && kq == 0) ? *(const f32x4*)(badd + ocol) : (f32x4){0.f, 0.f, 0.f, 0.f};
#pragma unroll
        for (int r = 0; r < 9; ++r) { f32x4 s = bb;
#pragma unroll
            for (int wv = 0; wv < 8; ++wv) s += red[(wv * 9 + r) * 64 + lane_];
            float* o = out + (size_t)r * ostride + ocol;
            unsafeAtomicAdd(o, s[0]); unsafeAtomicAdd(o + 1, s[1]); unsafeAtomicAdd(o + 2, s[2]); unsafeAtomicAdd(o + 3, s[3]); }
    }
    __syncthreads();
}
__device__ __forceinline__ void mod_vectors(Frame& F) {
    for (int t = blockIdx.x; t < 192; t += F.G) { const int kq = t & 3, tc = t >> 2, l = tc / 24, col = (tc % 24) * 256 + 4 * (threadIdx.x & 63);
        gemv9_tile<true>(F, nullptr, F.a.in[I_WADA] + (size_t)l * DM * 6144, 6144, col, true, F.a.in[I_BADA] + l * 6144, (float*)(F.a.ws + WS_MOD) + (size_t)l * 9 * 6144, 6144, col, kq); }
}
__device__ __forceinline__ void bias_vectors(Frame& F) {
    for (int t = blockIdx.x; t < 336; t += F.G) { const int kq = t & 3, tc = t >> 2, l = tc / 42, tt = tc % 42, lane_ = threadIdx.x & 63;
        const float* modl = (const float*)(F.a.ws + WS_MOD) + (size_t)l * 9 * 6144; float* bias = (float*)(F.a.ws + WS_BIAS) + (size_t)l * 9 * BIASW;
        if (tt < 10) { const int v = tt * 256 + 4 * lane_; const bool valid = !(v >= 416 && v < 512); const int oc = v < 416 ? v : v - 96;
            gemv9_tile<false>(F, modl, F.a.in[I_WIN] + (size_t)l * DM * INW, INW, valid ? oc : 0, valid, nullptr, bias, BIASW, v, kq); }
        else if (tt < 26) { const int c = (tt - 10) * 256 + 4 * lane_; gemv9_tile<false>(F, modl, F.a.in[I_WGATE] + (size_t)l * DM * 4096, 4096, c, true, nullptr, bias, BIASW, BIAS_G + c, kq); }
        else { const int c = (tt - 26) * 256 + 4 * lane_; gemv9_tile<false>(F, modl + 3 * 1024, F.a.in[I_FF1] + (size_t)l * DM * FF, FF, c, true, nullptr, bias, BIASW, BIAS_F + c, kq); } }
}

__device__ __forceinline__ void adaln_prep_rows(Frame& F, const float* xlat, const float* xctx, int nrows, const float* g, const float* scalev, bf16_t* H, float* ssq) {
    const int gw = F.vcu * NWAVES + F.wave, NGW = F.G * NWAVES;
    int lane_ = threadIdx.x; asm volatile("" : "+v"(lane_)); lane_ &= 63;
    for (int row = gw; row < nrows; row += NGW) {
        const float* xr = row < NLAT ? xlat + (size_t)row * DM : xctx + (size_t)(row - NLAT) * DM;
        const int r = row < NLAT ? (row >> 11) : 8;
        const float* sc = scalev + (size_t)r * 6144;
        f32x4 v[4]; float s = 0.f;
#pragma unroll
        for (int j = 0; j < 4; ++j) { v[j] = *(const f32x4*)(xr + 256 * j + 4 * lane_); s += (v[j][0] * v[j][0] + v[j][1] * v[j][1]) + (v[j][2] * v[j][2] + v[j][3] * v[j][3]); }
        s = wave_sum(s);
        if (lane_ == 0) ssq[row] = s;
#pragma unroll
        for (int j = 0; j < 4; ++j) {
            const int c = 256 * j + 4 * lane_;
            const f32x4 gg = *(const f32x4*)(g + c), s1 = *(const f32x4*)(sc + c);
            const f32x4 o = v[j] * gg * (s1 + 1.f);
            u32x2 w; w.x = cvt_pk_bf16(o[0], o[1]); w.y = cvt_pk_bf16(o[2], o[3]);
            *(u32x2*)(H + (size_t)row * DM + c) = w;
        }
    }
}
__device__ __forceinline__ void final_norm(Frame& F) {
    const int gw = F.vcu * NWAVES + F.wave, NGW = F.G * NWAVES;
    const float* g = F.a.in[I_FNORM];
    int lane_ = threadIdx.x; asm volatile("" : "+v"(lane_)); lane_ &= 63;
    for (int row = gw; row < NLAT; row += NGW) {
        float* xr = F.a.out + (size_t)row * DM;
        f32x4 v[4]; float s = 0.f;
#pragma unroll
        for (int j = 0; j < 4; ++j) { v[j] = *(const f32x4*)(xr + 256 * j + 4 * lane_); s += (v[j][0] * v[j][0] + v[j][1] * v[j][1]) + (v[j][2] * v[j][2] + v[j][3] * v[j][3]); }
        const float rstd = 1.f / sqrtf(wave_sum(s) * (1.f / DM) + EPS);
#pragma unroll
        for (int j = 0; j < 4; ++j) { const int c = 256 * j + 4 * lane_; const f32x4 gg = *(const f32x4*)(g + c); *(f32x4*)(xr + c) = v[j] * rstd * gg; }
    }
}

typedef float f32x16 __attribute__((ext_vector_type(16)));
typedef short s16x4 __attribute__((ext_vector_type(4)));
typedef short v4i16_t __attribute__((ext_vector_type(4)));
__device__ __forceinline__ int crow(int r, int hi) { return (r & 3) + 8 * (r >> 2) + 4 * hi; }
__device__ __forceinline__ s16x4 vtr(const LAS unsigned char* p) { return __builtin_bit_cast(s16x4, __builtin_amdgcn_ds_read_tr16_b64_v4i16((LAS v4i16_t*)p)); }
constexpr int AT_KVBUF = 21504, AT_KBYTES = 13312, AT_RPB = 4 * AT_KVBUF;
struct SetState { float m, l; f32x16 o0, o1; };
__device__ __forceinline__ void set_init(SetState& s) { s.m = -1e30f; s.l = 0.f;
#pragma unroll
    for (int r = 0; r < 16; ++r) { s.o0[r] = 0.f; s.o1[r] = 0.f; } }
struct StageRegs { u32x4 k1, k2, v; };
template <bool K2> __device__ __forceinline__ void stage_load(StageRegs& R, const bf16_t* k1, int p1, const bf16_t* k2, int p2, const bf16_t* v, int pv, int tid) {
    const int key = tid >> 3, ch = tid & 7;
    R.k1 = *(const u32x4*)(k1 + (size_t)key * p1 + ch * 8);
    R.v = *(const u32x4*)(v + (size_t)key * pv + ch * 8);
    if (K2) { if (tid < 256) R.k2 = *(const u32x4*)(k2 + (size_t)(tid >> 2) * p2 + (tid & 3) * 8); }
}
template <bool K2, int KSTRIDE> __device__ __forceinline__ void stage_write(LAS unsigned char* buf, const StageRegs& R, int tid) {
    const int key = tid >> 3, ch = tid & 7;
    *(LAS u32x4*)(buf + key * KSTRIDE + ch * 16) = R.k1;
    *(LAS u32x4*)(buf + AT_KBYTES + (ch >> 2) * 4096 + key * 64 + (ch & 3) * 16) = R.v;
    if (K2) { if (tid < 256) *(LAS u32x4*)(buf + (tid >> 2) * KSTRIDE + 128 + (tid & 3) * 16) = R.k2; }
}
template <int N> __device__ __forceinline__ void lgkm_wait() {
    static_assert(N >= 0 && N <= 15, "lgkmcnt range");
    if constexpr (N == 0) asm volatile("s_waitcnt lgkmcnt(0)" ::: "memory"); else if constexpr (N == 1) asm volatile("s_waitcnt lgkmcnt(1)" ::: "memory");
    else if constexpr (N == 2) asm volatile("s_waitcnt lgkmcnt(2)" ::: "memory"); else if constexpr (N == 3) asm volatile("s_waitcnt lgkmcnt(3)" ::: "memory");
    else if constexpr (N == 4) asm volatile("s_waitcnt lgkmcnt(4)" ::: "memory"); else if constexpr (N == 5) asm volatile("s_waitcnt lgkmcnt(5)" ::: "memory");
    else if constexpr (N == 6) asm volatile("s_waitcnt lgkmcnt(6)" ::: "memory"); else if constexpr (N == 7) asm volatile("s_waitcnt lgkmcnt(7)" ::: "memory");
    else if constexpr (N == 8) asm volatile("s_waitcnt lgkmcnt(8)" ::: "memory"); else if constexpr (N == 9) asm volatile("s_waitcnt lgkmcnt(9)" ::: "memory");
    else if constexpr (N == 10) asm volatile("s_waitcnt lgkmcnt(10)" ::: "memory"); else if constexpr (N == 11) asm volatile("s_waitcnt lgkmcnt(11)" ::: "memory");
    else if constexpr (N == 12) asm volatile("s_waitcnt lgkmcnt(12)" ::: "memory"); else if constexpr (N == 13) asm volatile("s_waitcnt lgkmcnt(13)" ::: "memory");
    else if constexpr (N == 14) asm volatile("s_waitcnt lgkmcnt(14)" ::: "memory"); else asm volatile("s_waitcnt lgkmcnt(15)" ::: "memory");
    __builtin_amdgcn_sched_barrier(0);
}
#define DS_READ_B128(dst, addr, off) asm volatile("ds_read_b128 %0, %1 offset:%c2" : "=v"(dst) : "v"(addr), "i"(off))
#define DS_READ_TR64(dst, addr, off) asm volatile("ds_read_b64_tr_b16 %0, %1 offset:%c2" : "=v"(dst) : "v"(addr), "i"(off))
template <int I, int N, int NST, int KSTRIDE> struct KIssue { static __device__ __forceinline__ void run(bf16x8* kf, unsigned ka) {
    DS_READ_B128(kf[I], ka, (I / NST) * 32 * KSTRIDE + (I % NST) * 32); KIssue<I + 1, N, NST, KSTRIDE>::run(kf, ka); } };
template <int N, int NST, int KSTRIDE> struct KIssue<N, N, NST, KSTRIDE> { static __device__ __forceinline__ void run(bf16x8*, unsigned) {} };
template <int I, int N, int NST> struct KConsume { static __device__ __forceinline__ void run(f32x16* p, const bf16x8* kf, const bf16x8* qf) {
    lgkm_wait<N - 1 - I>(); p[I / NST] = __builtin_amdgcn_mfma_f32_32x32x16_bf16(kf[I], qf[I % NST], p[I / NST], 0, 0, 0); KConsume<I + 1, N, NST>::run(p, kf, qf); } };
template <int N, int NST> struct KConsume<N, N, NST> { static __device__ __forceinline__ void run(f32x16*, const bf16x8*, const bf16x8*) {} };
template <int NST, int NSUB, int KSTRIDE> __device__ __forceinline__ void qk_tile(f32x16 (&p)[2], unsigned ka, const bf16x8* qf) {
    bf16x8 kf[NSUB * NST];
    KIssue<0, NSUB * NST, NST, KSTRIDE>::run(kf, ka);
#pragma unroll
    for (int sub = 0; sub < NSUB; ++sub)
#pragma unroll
        for (int r = 0; r < 16; ++r) p[sub][r] = 0.f;
    KConsume<0, NSUB * NST, NST>::run(p, kf, qf);
}
template <int NSUB> __device__ __forceinline__ void softmax_pack(SetState& st, f32x16 (&p)[NSUB], bf16x8 (&pf)[NSUB][2]) {
    float mx = p[0][0];
#pragma unroll
    for (int sub = 0; sub < NSUB; ++sub)
#pragma unroll
        for (int r = 0; r < 16; ++r) mx = fmaxf(mx, p[sub][r]);
    mx = fmaxf(mx, __shfl_xor(mx, 32));
    const float mn = fmaxf(st.m, mx), alpha = fast_exp2(st.m - mn); st.m = mn;
    float sum = 0.f;
#pragma unroll
    for (int sub = 0; sub < NSUB; ++sub)
#pragma unroll
        for (int r = 0; r < 16; ++r) { p[sub][r] = fast_exp2(p[sub][r] - mn); sum += p[sub][r]; }
    st.l = st.l * alpha + sum;
    if (__any(alpha != 1.f)) { st.o0 *= alpha; st.o1 *= alpha; }
#pragma unroll
    for (int sub = 0; sub < NSUB; ++sub)
#pragma unroll
        for (int s = 0; s < 2; ++s) { u32x4 w; w.x = cvt_pk_bf16(p[sub][8 * s + 0], p[sub][8 * s + 1]); w.y = cvt_pk_bf16(p[sub][8 * s + 2], p[sub][8 * s + 3]);
            w.z = cvt_pk_bf16(p[sub][8 * s + 4], p[sub][8 * s + 5]); w.w = cvt_pk_bf16(p[sub][8 * s + 6], p[sub][8 * s + 7]); pf[sub][s] = __builtin_bit_cast(bf16x8, w); }
}
template <int G> __device__ __forceinline__ void pv_issue(s16x4 (*vr)[4], unsigned va, int r0, int r1) {
    const unsigned a = va + (unsigned)(((G >> 1) ? r1 : r0) * 64);
    DS_READ_TR64(vr[G][0], a, (G & 1) * 1024); DS_READ_TR64(vr[G][1], a, (G & 1) * 1024 + 512); DS_READ_TR64(vr[G][2], a, (G & 1) * 1024 + 4096); DS_READ_TR64(vr[G][3], a, (G & 1) * 1024 + 4608);
}
template <int G, int NG, int NSETS> struct PvRun { static __device__ __forceinline__ void run(SetState (&st)[NSETS], const bf16x8 (&pf)[NSETS][2][2], s16x4 (*vr)[4], unsigned va, int r0, int r1) {
    if constexpr (G + 1 < NG) lgkm_wait<4>(); else lgkm_wait<0>();
    const bf16x8 v0 = {vr[G][0][0], vr[G][0][1], vr[G][0][2], vr[G][0][3], vr[G][1][0], vr[G][1][1], vr[G][1][2], vr[G][1][3]};
    const bf16x8 v1 = {vr[G][2][0], vr[G][2][1], vr[G][2][2], vr[G][2][3], vr[G][3][0], vr[G][3][1], vr[G][3][2], vr[G][3][3]};
#pragma unroll
    for (int z = 0; z < NSETS; ++z) { st[z].o0 = __builtin_amdgcn_mfma_f32_32x32x16_bf16(v0, pf[z][G >> 1][G & 1], st[z].o0, 0, 0, 0); st[z].o1 = __builtin_amdgcn_mfma_f32_32x32x16_bf16(v1, pf[z][G >> 1][G & 1], st[z].o1, 0, 0, 0); }
    if constexpr (G + 2 < NG) { __builtin_amdgcn_sched_barrier(0); pv_issue<G + 2>(vr, va, r0, r1); }
    PvRun<G + 1, NG, NSETS>::run(st, pf, vr, va, r0, r1); } };
template <int NG, int NSETS> struct PvRun<NG, NG, NSETS> { static __device__ __forceinline__ void run(SetState (&)[NSETS], const bf16x8 (&)[NSETS][2][2], s16x4 (*)[4], unsigned, int, int) {} };
template <int NSETS, int NG> __device__ __forceinline__ void pv_groups(SetState (&st)[NSETS], const bf16x8 (&pf)[NSETS][2][2], unsigned va, int r0, int r1) {
    s16x4 vr[NG][4];
    pv_issue<0>(vr, va, r0, r1);
    if constexpr (NG > 1) pv_issue<1>(vr, va, r0, r1);
    PvRun<0, NG, NSETS>::run(st, pf, vr, va, r0, r1);
}
__device__ __forceinline__ void softmax_pack1(SetState& st, f32x16 (&p)[2], bf16x8 (&pf)[2][2]) {
    float mx = p[0][0];
#pragma unroll
    for (int r = 1; r < 16; ++r) mx = fmaxf(mx, p[0][r]);
    mx = fmaxf(mx, __shfl_xor(mx, 32));
    const float mn = fmaxf(st.m, mx), alpha = fast_exp2(st.m - mn); st.m = mn;
    float sum = 0.f;
#pragma unroll
    for (int r = 0; r < 16; ++r) { p[0][r] = fast_exp2(p[0][r] - mn); sum += p[0][r]; }
    st.l = st.l * alpha + sum;
    if (__any(alpha != 1.f)) { st.o0 *= alpha; st.o1 *= alpha; }
#pragma unroll
    for (int s = 0; s < 2; ++s) { u32x4 w; w.x = cvt_pk_bf16(p[0][8 * s + 0], p[0][8 * s + 1]); w.y = cvt_pk_bf16(p[0][8 * s + 2], p[0][8 * s + 3]);
        w.z = cvt_pk_bf16(p[0][8 * s + 4], p[0][8 * s + 5]); w.w = cvt_pk_bf16(p[0][8 * s + 6], p[0][8 * s + 7]); pf[0][s] = __builtin_bit_cast(bf16x8, w); }
}
__device__ __forceinline__ void store_o(bf16_t* orow, const f32x16& o0, const f32x16& o1, int hi) {
#pragma unroll
    for (int g = 0; g < 4; ++g) {
        u32x2 w; w.x = cvt_pk_bf16(o0[4 * g], o0[4 * g + 1]); w.y = cvt_pk_bf16(o0[4 * g + 2], o0[4 * g + 3]); *(u32x2*)(orow + 8 * g + 4 * hi) = w;
        w.x = cvt_pk_bf16(o1[4 * g], o1[4 * g + 1]); w.y = cvt_pk_bf16(o1[4 * g + 2], o1[4 * g + 3]); *(u32x2*)(orow + 32 + 8 * g + 4 * hi) = w;
    }
}
template <int N> __device__ __forceinline__ void load_qf(bf16x8 (&qf)[N], const bf16_t* q, int hi) {
#pragma unroll
    for (int s = 0; s < N; ++s) qf[s] = *(const bf16x8*)(q + 16 * s + 8 * hi);
}
struct AttnBufs { const bf16_t* P; const bf16_t* Q; bf16_t* O; const float* dlam; const float* subln; const float* sink; const float* rpb; float lam_init; bool need_ctx; };
struct AttnLane { int tid, lane, q31, hi, wave, voff; };
__device__ __forceinline__ AttnLane make_lane() {
    AttnLane A; A.tid = threadIdx.x; asm volatile("" : "+v"(A.tid)); A.lane = A.tid & 63; A.q31 = A.lane & 31; A.hi = A.lane >> 5; A.wave = __builtin_amdgcn_readfirstlane(A.tid >> 6);
    A.voff = ((A.lane >> 4) & 1) * 32 + (A.lane & 3) * 8 + (4 * A.hi + ((A.lane & 15) >> 2)) * 64; return A;
}
#define AT_BAR() asm volatile("s_waitcnt lgkmcnt(0)\n\ts_barrier" ::: "memory")
template <int NSETS, bool K2, int KSTRIDE, class LoadF, class QKF>
__device__ __forceinline__ void attn_pipeline(int nt, LAS unsigned char* lds, const AttnLane& A, SetState (&st)[NSETS], LoadF load, QKF qk) {
    const int grp = A.wave >> 2;
    const unsigned lds0 = (unsigned)(uintptr_t)lds;
    StageRegs R;
    load(0, R); stage_write<K2, KSTRIDE>(lds, R, A.tid);
    if (nt > 1) { load(1, R); stage_write<K2, KSTRIDE>(lds + AT_KVBUF, R, A.tid); }
    if (nt > 2) load(2, R);
    AT_BAR();
    if (grp == 1) AT_BAR();
    f32x16 p[NSETS][2]; bf16x8 pf[NSETS][2][2];
    int nsub_prev = 0, sr0_prev = 0, sr1_prev = 0;
    for (int t = 0; t < nt; ++t) {
        int sr0 = 0, sr1 = 32;
        const int nsub = qk(lds0 + (unsigned)((t & 3) * AT_KVBUF), t, p, sr0, sr1);
        if (nsub_prev) { const unsigned va = lds0 + (unsigned)(((t - 1) & 3) * AT_KVBUF + AT_KBYTES + A.voff);
            if (nsub_prev == 2) pv_groups<NSETS, 4>(st, pf, va, sr0_prev, sr1_prev); else pv_groups<NSETS, 2>(st, pf, va, sr0_prev, sr0_prev); }
        AT_BAR();
        if (nsub == 2) {
#pragma unroll
            for (int z = 0; z < NSETS; ++z) softmax_pack<2>(st[z], p[z], pf[z]);
        } else if (nsub == 1) {
#pragma unroll
            for (int z = 0; z < NSETS; ++z) softmax_pack1(st[z], p[z], pf[z]);
        }
        nsub_prev = nsub; sr0_prev = sr0; sr1_prev = sr1;
        if (t + 2 < nt) stage_write<K2, KSTRIDE>(lds + ((t + 2) & 3) * AT_KVBUF, R, A.tid);
        if (t + 3 < nt) load(t + 3, R);
        AT_BAR();
    }
    if (nsub_prev) { const unsigned va = lds0 + (unsigned)(((nt - 1) & 3) * AT_KVBUF + AT_KBYTES + A.voff);
        if (nsub_prev == 2) pv_groups<NSETS, 4>(st, pf, va, sr0_prev, sr1_prev); else pv_groups<NSETS, 2>(st, pf, va, sr0_prev, sr0_prev); }
    AT_BAR();
    if (grp == 0) AT_BAR();
}

__device__ __forceinline__ void attn_mla(const AttnBufs& T, LAS unsigned char* lds, int b, int h, int qblk, bool ctxq) {
    const AttnLane A = make_lane();
    const int row = (ctxq ? NLAT + b * CTXL : b * SEQ + qblk * 256) + A.wave * 32 + A.q31;
    bf16x8 qf[6]; load_qf<6>(qf, T.Q + (size_t)row * QW + 96 * h, A.hi);
    SetState st[1]; set_init(st[0]);
    const int nt = ctxq ? 4 : 36;
    attn_pipeline<1, true, 208>(nt, lds, A, st,
        [&](int t, StageRegs& R) { const int rb = t < 4 ? NLAT + b * CTXL + 64 * t : b * SEQ + 64 * (t - 4);
            stage_load<true>(R, T.Q + (size_t)rb * QW + UC_KV + 128 * h, QW, T.P + (size_t)rb * PW + PC_KR, PW, T.Q + (size_t)rb * QW + UC_KV + 128 * h + 64, QW, A.tid); },
        [&](unsigned buf, int, f32x16 (&p)[1][2], int&, int&) -> int { qk_tile<6, 2, 208>(p[0], buf + (unsigned)(A.q31 * 208 + A.hi * 16), qf); return 2; });
    float l = st[0].l; l += __shfl_xor(l, 32); const float il = 1.f / l;
    st[0].o0 *= il; st[0].o1 *= il;
    store_o(T.O + (size_t)row * DM + 0 + 64 * h, st[0].o0, st[0].o1, A.hi);
}
__device__ __forceinline__ void attn_diff(const AttnBufs& T, LAS unsigned char* lds, int b, int h, int qblk, bool ctxq) {
    const AttnLane A = make_lane();
    const int row = (ctxq ? NLAT + b * CTXL : b * SEQ + qblk * 256) + A.wave * 32 + A.q31;
    bf16x8 q1[2], q2[2]; load_qf<2>(q1, T.P + (size_t)row * PW + PC_DQ + 64 * h, A.hi); load_qf<2>(q2, T.P + (size_t)row * PW + PC_DQ + 64 * h + 32, A.hi);
    SetState st[2]; set_init(st[0]); set_init(st[1]);
    const int nt = ctxq ? 4 : 36;
    attn_pipeline<2, false, 144>(nt, lds, A, st,
        [&](int t, StageRegs& R) { const int rb = t < 4 ? NLAT + b * CTXL + 64 * t : b * SEQ + 64 * (t - 4);
            stage_load<false>(R, T.P + (size_t)rb * PW + PC_DK + 64 * h, PW, nullptr, 0, T.P + (size_t)rb * PW + PC_DV + 64 * h, PW, A.tid); },
        [&](unsigned buf, int, f32x16 (&p)[2][2], int&, int&) -> int {
            qk_tile<2, 2, 144>(p[0], buf + (unsigned)(A.q31 * 144 + A.hi * 16), q1); qk_tile<2, 2, 144>(p[1], buf + (unsigned)(A.q31 * 144 + A.hi * 16 + 64), q2); return 2; });
    float a0 = 0.f, a1 = 0.f;
#pragma unroll
    for (int i = 0; i < 32; ++i) { a0 += T.dlam[i] * T.dlam[32 + i]; a1 += T.dlam[64 + i] * T.dlam[96 + i]; }
    const float lam = __expf(a0) - __expf(a1) + T.lam_init;
    float l1 = st[0].l, l2 = st[1].l; l1 += __shfl_xor(l1, 32); l2 += __shfl_xor(l2, 32);
    const float i1 = 1.f / l1, i2 = lam / l2;
    f32x16 o0 = st[0].o0 * i1 - st[1].o0 * i2, o1 = st[0].o1 * i1 - st[1].o1 * i2;
    float ss = 0.f;
#pragma unroll
    for (int r = 0; r < 16; ++r) ss += o0[r] * o0[r] + o1[r] * o1[r];
    ss += __shfl_xor(ss, 32);
    const float rs = (1.f / sqrtf(ss * (1.f / 64.f) + EPS)) * (1.f - T.lam_init);
#pragma unroll
    for (int r = 0; r < 16; ++r) { o0[r] *= rs * T.subln[crow(r, A.hi)]; o1[r] *= rs * T.subln[32 + crow(r, A.hi)]; }
    store_o(T.O + (size_t)row * DM + 256 + 64 * h, o0, o1, A.hi);
}
__device__ __forceinline__ void attn_win(const AttnBufs& T, LAS unsigned char* lds, int b, int kvh, int n, bool ctxq) {
    const AttnLane A = make_lane();
    const int hq = 2 * kvh + (A.wave >> 2);
    const int qpos = n * 128 + (A.wave & 3) * 32 + A.q31;
    const int row = (ctxq ? NLAT + b * CTXL : b * SEQ) + qpos;
    bf16x8 qf[4]; load_qf<4>(qf, T.P + (size_t)row * PW + PC_WQ + 64 * hq, A.hi);
    SetState st[1]; set_init(st[0]);
    const int lt0 = (n == 0) ? 2 : 0, lt1 = (n == 15) ? 3 : 5;
    const int nt = ctxq ? 4 : 4 + (lt1 - lt0 + 1);
    const int q0 = n * 128 + (A.wave & 3) * 32;
    attn_pipeline<1, false, 144>(nt, lds, A, st,
        [&](int t, StageRegs& R) { const int rb = t < 4 ? NLAT + b * CTXL + 64 * t : b * SEQ + n * 128 - 128 + 64 * (lt0 + t - 4);
            stage_load<false>(R, T.P + (size_t)rb * PW + PC_WK + 64 * kvh, PW, nullptr, 0, T.P + (size_t)rb * PW + PC_WV + 64 * kvh, PW, A.tid); },
        [&](unsigned buf, int t, f32x16 (&p)[1][2], int&, int&) -> int {
            const int kp0 = n * 128 - 128 + 64 * (lt0 + t - 4);
            if (t >= 4 && (kp0 > q0 + 31 + 128 || kp0 + 63 < q0 - 128)) return 0;
            qk_tile<4, 2, 144>(p[0], buf + (unsigned)(A.q31 * 144 + A.hi * 16), qf);
            if (t >= 4) {
#pragma unroll
                for (int sub = 0; sub < 2; ++sub)
#pragma unroll
                    for (int r = 0; r < 16; ++r) { const int d = qpos - (kp0 + 32 * sub + crow(r, A.hi)); if (d > 128 || d < -128) p[0][sub][r] = -1e30f; }
            }
            return 2; });
    float l = st[0].l; l += __shfl_xor(l, 32); l += fast_exp2(T.sink[hq] * LOG2E - st[0].m);
    const float il = 1.f / l; st[0].o0 *= il; st[0].o1 *= il;
    store_o(T.O + (size_t)row * DM + 512 + 64 * hq, st[0].o0, st[0].o1, A.hi);
}
__device__ __forceinline__ int na_rs(int r) { int s = r - 4; return s < 0 ? 0 : (s > 24 ? 24 : s); }
__device__ __forceinline__ void attn_na(const AttnBufs& T, LAS unsigned char* lds, int b, int h, int rq) {
    const AttnLane A = make_lane();
    const int R0 = 4 * rq, qr0 = R0 + 2 * (A.wave >> 2), cb = A.wave & 3;
    const int qrow = qr0 + (A.q31 >> 4), qcol = 16 * cb + (A.q31 & 15);
    const int row = b * SEQ + 64 * qrow + qcol;
    bf16x8 qf[4]; load_qf<4>(qf, T.P + (size_t)row * PW + PC_NQ + 64 * h, A.hi);
    LAS float* bias = (LAS float*)(lds + AT_RPB);
    for (int i = A.tid; i < 15 * 31; i += 512) bias[i] = T.rpb[h * 15 * 31 + i] * LOG2E;
    SetState st[1]; set_init(st[0]);
    const int krlo = na_rs(R0), krhi = na_rs(R0 + 3) + 7;
    const int nt = 4 + (krhi - krlo + 1);
    const int col0 = cb == 0 ? 0 : (cb == 1 ? 8 : (cb == 2 ? 24 : 32));
    const int rs_q = na_rs(qrow); int cs_q = qcol - 8; cs_q = cs_q < 0 ? 0 : (cs_q > 48 ? 48 : cs_q);
    const int wlo = na_rs(qr0), whi = na_rs(qr0 + 1) + 7;
    attn_pipeline<1, false, 144>(nt, lds, A, st,
        [&](int t, StageRegs& R) { const int rb = t < 4 ? NLAT + b * CTXL + 64 * t : b * SEQ + 64 * (krlo + t - 4);
            stage_load<false>(R, T.P + (size_t)rb * PW + PC_NK + 64 * h, PW, nullptr, 0, T.P + (size_t)rb * PW + PC_NV + 64 * h, PW, A.tid); },
        [&](unsigned buf, int t, f32x16 (&p)[1][2], int& sr0, int&) -> int {
            if (t < 4) { qk_tile<4, 2, 144>(p[0], buf + (unsigned)(A.q31 * 144 + A.hi * 16), qf); return 2; }
            const int kr = krlo + t - 4;
            if (kr < wlo || kr > whi) return 0;
            sr0 = col0;
            qk_tile<4, 1, 144>(p[0], buf + (unsigned)((col0 + A.q31) * 144 + A.hi * 16), qf);
            const bool rv = kr >= rs_q && kr < rs_q + 8;
#pragma unroll
            for (int r = 0; r < 16; ++r) { const int kc = col0 + crow(r, A.hi); const bool ok = rv && kc >= cs_q && kc < cs_q + 16;
                int bi = (kr - qrow + 7) * 31 + (kc - qcol + 15); bi = ok ? bi : 0;
                p[0][0][r] = ok ? p[0][0][r] + bias[bi] : -1e30f; }
            return 1; });
    float l = st[0].l; l += __shfl_xor(l, 32); const float il = 1.f / l;
    st[0].o0 *= il; st[0].o1 *= il;
    store_o(T.O + (size_t)row * DM + 768 + 64 * h, st[0].o0, st[0].o1, A.hi);
}
__device__ __forceinline__ void attn_na_ctx(const AttnBufs& T, LAS unsigned char* lds, int b, int h) {
    const AttnLane A = make_lane();
    const int row = NLAT + b * CTXL + A.wave * 32 + A.q31;
    bf16x8 qf[4]; load_qf<4>(qf, T.P + (size_t)row * PW + PC_NQ + 64 * h, A.hi);
    SetState st[1]; set_init(st[0]);
    attn_pipeline<1, false, 144>(4, lds, A, st,
        [&](int t, StageRegs& R) { const int rb = NLAT + b * CTXL + 64 * t;
            stage_load<false>(R, T.P + (size_t)rb * PW + PC_NK + 64 * h, PW, nullptr, 0, T.P + (size_t)rb * PW + PC_NV + 64 * h, PW, A.tid); },
        [&](unsigned buf, int, f32x16 (&p)[1][2], int&, int&) -> int { qk_tile<4, 2, 144>(p[0], buf + (unsigned)(A.q31 * 144 + A.hi * 16), qf); return 2; });
    float l = st[0].l; l += __shfl_xor(l, 32); const float il = 1.f / l;
    st[0].o0 *= il; st[0].o1 *= il;
    store_o(T.O + (size_t)row * DM + 768 + 64 * h, st[0].o0, st[0].o1, A.hi);
}

__device__ __forceinline__ void attn_phase(Frame& F, const AttnBufs& T) {
    for (int u = F.vcu; u < 256; u += F.G) {
        for (int rep = 0; rep < REP_MLA; ++rep) attn_mla(T, F.lds, u >> 5, (u >> 3) & 3, u & 7, false);
        for (int rep = 0; rep < REP_DIFF; ++rep) attn_diff(T, F.lds, u >> 5, (u >> 3) & 3, u & 7, false);
        for (int rep = 0; rep < REP_WIN; ++rep) attn_win(T, F.lds, u >> 5, (u >> 4) & 1, u & 15, false);
        for (int rep = 0; rep < REP_NA; ++rep) attn_na(T, F.lds, u >> 5, (u >> 3) & 3, u & 7);
    }
    if (T.need_ctx) for (int u = F.vcu; u < 128; u += F.G) {
        const int br = u & 3, w = u >> 2, b = w >> 2, x = w & 3;
        if (br == 0) attn_mla(T, F.lds, b, x, 0, true);
        else if (br == 1) attn_diff(T, F.lds, b, x, 0, true);
        else if (br == 2) attn_win(T, F.lds, b, x >> 1, x & 1, true);
        else attn_na_ctx(T, F.lds, b, x);
    }
}

__global__ void __launch_bounds__(NWAVES * 64, 2) mega(Args args) {
    extern __shared__ __attribute__((aligned(16))) unsigned char lds[];
    Frame F;
    F.lds = (LAS unsigned char*)lds; F.wave = __builtin_amdgcn_readfirstlane(threadIdx.x >> 6);
    F.G = gridDim.x; { const int bx = blockIdx.x; F.vcu = (F.G % 8 == 0) ? (bx % 8) * (F.G / 8) + bx / 8 : bx; }
    F.a = args;
    volatile LAS unsigned* MISC = (volatile LAS unsigned*)(F.lds + MISC_OFF);
    for (int u = threadIdx.x; u < (LDS_BYTES - RING_BYTES) / 4; u += NWAVES * 64) ((LAS unsigned*)(F.lds + RING_BYTES))[u] = 0u;
    __syncthreads();
    unsigned* ctl = (unsigned*)args.ws;
    XcdBarrier bar = xcd_barrier_post(ctl + CW_BAR, MISC + 8);
    unsigned char* ws = args.ws;
    const int lo = args.ph_lo, hi = args.ph_hi;
    bool first_bar = true;
#define IN(k) (lo <= (k) && (k) < hi)
#define SEAM(k) do { if (IN(k) && IN((k) + 1)) { if (first_bar && !PROBE_NOCG) { cg::this_grid().sync(); first_bar = false; } else { xcd_barrier(bar); for (int xb = 0; xb < PROBE_BAR; ++xb) xcd_barrier(bar); } } } while (0)
    float* modall = (float*)(ws + WS_MOD);
    float* ssq = (float*)(ws + WS_SSQ);
    float* biasall = (float*)(ws + WS_BIAS);
    bf16_t* Wt_in = (bf16_t*)(ws + WS_WIN); bf16_t* Wt_up = (bf16_t*)(ws + WS_WUP); bf16_t* Wt_g = (bf16_t*)(ws + WS_WGATE); bf16_t* Wt_b = (bf16_t*)(ws + WS_WBR);
    bf16_t* Wt_o = (bf16_t*)(ws + WS_WOUT); bf16_t* Wt_1 = (bf16_t*)(ws + WS_WFF1);
    float* XC = (float*)(ws + WS_XC);
    int ph = 0;
    if (IN(ph)) for (int rep = 0; rep < PROBE_P0; ++rep) { mod_vectors(F); convert_weights(F, 0, WS_WFF2, 0); __syncthreads(); }
    SEAM(ph); ++ph;
    if (IN(ph)) for (int rep = 0; rep < PROBE_ELEM; ++rep) { bias_vectors(F);
        adaln_prep_rows(F, F.a.in[I_X], F.a.in[I_CTX], NTOK, F.a.in[I_NMIX], modall + 1 * 1024, (bf16_t*)F.a.out, ssq + (size_t)4 * NTOK); __syncthreads(); }
    SEAM(ph); ++ph;
#pragma nounroll
    for (int l = 0; l < 2; ++l) {
        const bool need_ctx = (l == 0);
        const int nMall = NTOK / 256, nMlat = need_ctx ? NTOK / 256 : NLAT / 256;
        bf16_t* H   = l == 0 ? (bf16_t*)F.a.out : (bf16_t*)(ws + 46 * MiB);
        bf16_t* Pb  = (bf16_t*)(ws + (l == 0 ? 46 : 82) * MiB);
        bf16_t* Qb  = (bf16_t*)(ws + (l == 0 ? 136 : 172) * MiB);
        bf16_t* OY  = (bf16_t*)(ws + (l == 0 ? 220 : 216) * MiB);
        bf16_t* Bc  = Pb;
        bf16_t* H2  = (bf16_t*)(ws + (l == 0 ? 46 : 82) * MiB);
        bf16_t* U   = (bf16_t*)(ws + (l == 0 ? 82 : 118) * MiB);
        bf16_t* Wt_2 = (bf16_t*)(ws + (l == 0 ? WS_WFF2 : WS_W2L1));
        const float* modl = modall + (size_t)l * 9 * 6144;
        const float* biasl = biasall + (size_t)l * 9 * BIASW;
        float* ssq_q = ssq + (size_t)(2 * l) * NTOK; float* ssq_kv = ssq + (size_t)(2 * l + 1) * NTOK;
        float* ssq_h = ssq + (size_t)(4 + l) * NTOK; float* ssq_h2 = ssq + (size_t)(6 + l) * NTOK;
        const float* xlat = l == 0 ? F.a.in[I_X] : F.a.out; const float* xctx = l == 0 ? F.a.in[I_CTX] : XC;
        if (IN(ph)) { pg8::Prob g = pg8::plain_prob(H, DM, Wt_in, DM); pg8::StaticOrder S; S.init(nMall, PW / 256, F.G, (int)blockIdx.x);
            EpiP E{Pb, ssq_q, ssq_kv, ssq_h, biasl}; pg8::gemm_phase<EpiP, pg8::Prob, pg8::StaticOrder, true, true>(F.lds, g, S, E); }
        SEAM(ph); ++ph;
        if (IN(ph)) { pg8::Prob g = pg8::plain_prob(Pb, PW, Wt_up, 384); g.nt = 6; pg8::StaticOrder S; S.init(nMall, 4, F.G, (int)blockIdx.x);
            EpiUp E{Qb, ssq_q, ssq_kv}; for (int rep = 0; rep < PROBE_UP; ++rep) { pg8::gemm_phase<EpiUp, pg8::Prob, pg8::StaticOrder, true, true>(F.lds, g, S, E); __syncthreads(); } }
        SEAM(ph); ++ph;
        if (IN(ph)) { AttnBufs T{Pb, Qb, OY, F.a.in[I_DLAM] + l * 128, F.a.in[I_SUBLN] + l * 64, F.a.in[I_SINK] + l * 4, F.a.in[I_RPB] + l * 4 * 15 * 31, l == 0 ? 0.2f : 0.35550907f, need_ctx};
            for (int rep = 0; rep < PROBE_ATTN; ++rep) { attn_phase(F, T); __syncthreads(); } }
        SEAM(ph); ++ph;
        if (IN(ph)) { pg8::Prob g; g.A = (const char*)OY; g.B = (const char*)Wt_b; g.nt = 4; g.lda = DM; g.ldb = DM; g.hstepB = (size_t)128 * DM * 2;
            g.a_pm = (size_t)256 * DM * 2; g.a_pnhi = 512; g.a_sh = 2; g.b_pnlo = (size_t)256 * DM * 2; g.b_pnhi = 512; g.b_mask = 3; g.b_sh = 2;
            pg8::StaticOrder S; S.init(nMlat, 16, F.G, (int)blockIdx.x);
            EpiBf16<0> E{Bc, 4096, nullptr, nullptr}; for (int rep = 0; rep < PROBE_MERGE; ++rep) { pg8::gemm_phase<EpiBf16<0>, pg8::Prob, pg8::StaticOrder, true, true>(F.lds, g, S, E); __syncthreads(); } }
        SEAM(ph); ++ph;
        if (IN(ph)) { pg8::Prob g; g.A = (const char*)H; g.B = (const char*)Wt_g; g.nt = 16; g.lda = DM; g.ldb = DM; g.hstepB = (size_t)2048 * DM * 2;
            g.a_pm = (size_t)256 * DM * 2; g.a_pnhi = 0; g.a_sh = 0; g.b_pnlo = (size_t)64 * DM * 2; g.b_pnhi = 0; g.b_mask = ~0; g.b_sh = 0;
            pg8::StaticOrder S; S.init(nMlat, 16, F.G, (int)blockIdx.x);
            EpiMerge E{OY, Bc, F.a.in[I_BGATE] + l * 4096, ssq_h, biasl + BIAS_G}; for (int rep = 0; rep < PROBE_MERGE; ++rep) { pg8::gemm_phase<EpiMerge, pg8::Prob, pg8::StaticOrder, true, true>(F.lds, g, S, E); __syncthreads(); } }
        SEAM(ph); ++ph;
        if (IN(ph)) { pg8::Prob g = pg8::plain_prob(OY, DM, Wt_o, DM); pg8::StaticOrder S; S.init(nMlat, 4, F.G, (int)blockIdx.x);
            EpiRes<true> E{xlat, xctx, F.a.out, XC, modl + 2 * 1024, H2, F.a.in[I_NFFN] + l * DM, modl + 4 * 1024, ssq_h2};
            pg8::gemm_phase<EpiRes<true>, pg8::Prob, pg8::StaticOrder, true, true>(F.lds, g, S, E); }
        SEAM(ph); ++ph;
        if (IN(ph)) { pg8::Prob g = pg8::plain_prob(H2, DM, Wt_1, DM); pg8::StaticOrder S; S.init(nMlat, 16, F.G, (int)blockIdx.x);
            EpiBf16<1> E{U, FF, ssq_h2, biasl + BIAS_F}; for (int rep = 0; rep < PROBE_FF1; ++rep) { pg8::gemm_phase<EpiBf16<1>, pg8::Prob, pg8::StaticOrder, true, true>(F.lds, g, S, E); __syncthreads(); } }
        SEAM(ph); ++ph;
        if (IN(ph)) { pg8::Prob g = pg8::plain_prob(U, FF, Wt_2, FF); pg8::StaticOrder S; S.init(nMlat, 4, F.G, (int)blockIdx.x);
            if (l == 0) { EpiRes<true> E{F.a.out, XC, F.a.out, XC, modl + 5 * 1024, (bf16_t*)(ws + 46 * MiB), F.a.in[I_NMIX] + DM, modall + (size_t)9 * 6144 + 1 * 1024, ssq + (size_t)5 * NTOK};
                pg8::gemm_phase<EpiRes<true>, pg8::Prob, pg8::StaticOrder, true, true>(F.lds, g, S, E);
                __syncthreads(); convert_weights(F, 1, WS_W2L1, 32); }
            else { EpiRes<false> E{F.a.out, XC, F.a.out, XC, modl + 5 * 1024, nullptr, nullptr, nullptr, nullptr};
                pg8::gemm_phase<EpiRes<false>, pg8::Prob, pg8::StaticOrder, true, true>(F.lds, g, S, E); } }
        SEAM(ph); ++ph;
    }
    if (IN(ph)) final_norm(F);
#undef IN
#undef SEAM
}

constexpr int N_PHASES = 2 + 2 * 8 + 1;

extern "C" void kernel_launch(void* const* d_in, const int* in_sizes, int n_in, void* d_out, int out_size, void* d_ws, size_t ws_size, hipStream_t stream) {
    static int grid = 0;
    if (grid == 0) {
        int dev = 0, cus = 0, per_cu = 0;
        if (n_in != 24 || out_size != NLAT * DM || ws_size < 256 * MiB) { fprintf(stderr, "kernel_launch: unexpected shapes (n_in %d out %d ws %zu)\n", n_in, out_size, ws_size); grid = -1; return; }
        if (hipGetDevice(&dev) != hipSuccess || hipDeviceGetAttribute(&cus, hipDeviceAttributeMultiprocessorCount, dev) != hipSuccess) { grid = -1; return; }
        if (hipFuncSetAttribute((const void*)mega, hipFuncAttributeMaxDynamicSharedMemorySize, LDS_BYTES) != hipSuccess) { fprintf(stderr, "hipFuncSetAttribute failed\n"); grid = -1; return; }
        if (hipOccupancyMaxActiveBlocksPerMultiprocessor(&per_cu, (const void*)mega, NWAVES * 64, LDS_BYTES) != hipSuccess || per_cu < 1) { fprintf(stderr, "occupancy query: %d\n", per_cu); grid = -1; return; }
        (void)hipGetLastError();
        grid = cus;
    }
    if (grid < 0) return;
    (void)hipMemsetAsync(d_ws, 0, CTL_ZERO_BYTES, stream);
    Args a{};
    for (int i = 0; i < 24; ++i) a.in[i] = (const float*)d_in[i];
    a.out = (float*)d_out; a.ws = (unsigned char*)d_ws; a.ph_lo = 0; a.ph_hi = N_PHASES;
    void* kargs[] = {&a};
    hipError_t e = hipLaunchCooperativeKernel((const void*)mega, dim3(grid), dim3(NWAVES * 64), kargs, LDS_BYTES, stream);
    if (e != hipSuccess) fprintf(stderr, "cooperative launch failed: %s (grid %d)\n", hipGetErrorString(e), grid);
}
```
